# Optimizing an MI355X kernel written in HIP

```python
import numpy as np
import jax
import jax.numpy as jnp
from jax import lax

D_MODEL = 2048
BATCH = 2
SEQ = 4096
DEPTH = 2
DEC_BATCH = 16
DEC_SEQ = 32
PAST_LEN = 1024

CHUNK = 64
N_EVEN = (DEPTH + 1) // 2
N_ODD = DEPTH // 2
HEAD_DIM = 64
N_Q_HEADS = 16
N_KV_HEADS = 4
Q_PER_KV = N_Q_HEADS // N_KV_HEADS
WINDOW = 128
N_RET_HEADS = 8
RET_DK = 128
RET_DV = 128
ROPE_BASE = 10000.0
GM_CHUNK = 128
GM_WIDTH = D_MODEL
GM_GROUPS = 8
GM_GROUP_DIM = GM_WIDTH // GM_GROUPS
D_FF = 5632
CONV_W = 3
EPS = 1e-6
EVEN_SIZES = (N_Q_HEADS * HEAD_DIM, N_KV_HEADS * HEAD_DIM, N_KV_HEADS * HEAD_DIM,
              N_RET_HEADS * RET_DK, N_RET_HEADS * RET_DK, N_RET_HEADS * RET_DV, N_RET_HEADS * RET_DV)
EVEN_IN = 1024 + 256 + 256 + 1024 + 1024 + 1024 + 1024
EVEN_MIX = N_Q_HEADS * HEAD_DIM + N_RET_HEADS * RET_DV

kernel_name = "hybrid_swa_retention_gmlp_convffn_stream_step"

F32 = jnp.float32


def rms_norm(x, g):
    xf = x.astype(F32)
    y = xf * lax.rsqrt(jnp.mean(xf * xf, axis=-1, keepdims=True) + EPS)
    return (y * g.astype(F32)).astype(x.dtype)


def layer_norm(x, g, b):
    xf = x.astype(F32)
    mu = jnp.mean(xf, axis=-1, keepdims=True)
    xc = xf - mu
    y = xc * lax.rsqrt(jnp.mean(xc * xc, axis=-1, keepdims=True) + EPS)
    return y * g.astype(F32) + b.astype(F32)


def head_norm(y, g):
    B, T = y.shape[0], y.shape[1]
    mu = jnp.mean(y, axis=-1, keepdims=True)
    yc = y - mu
    yn = yc * lax.rsqrt(jnp.mean(yc * yc, axis=-1, keepdims=True) + EPS)
    return yn.reshape(B, T, N_RET_HEADS * RET_DV) * g.astype(F32)


def rope(x, pos):
    half = x.shape[-1] // 2
    freq = 1.0 / (ROPE_BASE ** (jnp.arange(half, dtype=F32) / half))
    ang = pos.astype(F32)[:, None] * freq[None, :]
    cos = jnp.cos(ang)[None, :, None, :]
    sin = jnp.sin(ang)[None, :, None, :]
    xf = x.astype(F32)
    x1, x2 = xf[..., :half], xf[..., half:]
    return jnp.concatenate([x1 * cos - x2 * sin, x2 * cos + x1 * sin], axis=-1)


def ret_log_gamma():
    return jnp.log1p(-jnp.exp2(-5.0 - jnp.arange(N_RET_HEADS, dtype=F32)))


def decay_terms(log_g, n):
    idx = jnp.arange(n, dtype=F32)
    diff = idx[:, None] - idx[None, :]
    intra = jnp.where(diff[None] >= 0.0,
                      jnp.exp(log_g[:, None, None] * jnp.maximum(diff, 0.0)[None]), 0.0)
    q_decay = jnp.exp(log_g[:, None] * (idx[None, :] + 1.0))
    k_decay = jnp.exp(log_g[:, None] * (n - 1.0 - idx)[None, :])
    chunk_decay = jnp.exp(log_g * n)
    return intra, q_decay, k_decay, chunk_decay


def retention_prompt(q, k, v, log_g):
    B, S = q.shape[0], q.shape[1]
    nc = S // CHUNK
    qc = q.reshape(B, nc, CHUNK, N_RET_HEADS, RET_DK)
    kc = k.reshape(B, nc, CHUNK, N_RET_HEADS, RET_DK)
    vc = v.reshape(B, nc, CHUNK, N_RET_HEADS, RET_DV)
    intra, q_decay, k_decay, chunk_decay = decay_terms(log_g, CHUNK)
    scores = jnp.einsum('bnihd,bnjhd->bnhij', qc, kc) * intra
    inner = jnp.einsum('bnhij,bnjhe->bnihe', scores, vc)
    kv = jnp.einsum('bnjhd,hj,bnjhe->bnhde', kc, k_decay, vc)

    def step(state, kv_n):
        return chunk_decay[None, :, None, None] * state + kv_n, state

    s0 = jnp.zeros((B, N_RET_HEADS, RET_DK, RET_DV), kv.dtype)
    s_final, s_prev = lax.scan(step, s0, jnp.moveaxis(kv, 1, 0))
    s_prev = jnp.moveaxis(s_prev, 0, 1)
    cross = jnp.einsum('bnihd,bnhde->bnihe', qc, s_prev) * q_decay.T[None, None, :, :, None]
    return (inner + cross).reshape(B, S, N_RET_HEADS, RET_DV), s_final


def retention_sample(q, k, v, state, log_g):
    T = q.shape[1]
    intra, q_decay, k_decay, chunk_decay = decay_terms(log_g, T)
    st = state.astype(F32)
    scores = jnp.einsum('bihd,bjhd->bhij', q, k) * intra
    inner = jnp.einsum('bhij,bjhe->bihe', scores, v)
    cross = jnp.einsum('bihd,bhde->bihe', q, st) * q_decay.T[None, :, :, None]
    new_state = chunk_decay[None, :, None, None] * st + jnp.einsum('bjhd,hj,bjhe->bhde', k, k_decay, v)
    return inner + cross, new_state


def sink_softmax(s, sink):
    sk = sink[:, :, None, None]
    m = jnp.maximum(jnp.max(s, axis=-1, keepdims=True), sk)
    p = jnp.exp(s - m)
    return p / (jnp.sum(p, axis=-1, keepdims=True) + jnp.exp(sk - m))


def swa_prompt(q, k, v, sink):
    B, S = q.shape[0], q.shape[1]
    nc, nb = S // CHUNK, WINDOW // CHUNK
    pad = ((0, 0), (WINDOW, 0), (0, 0), (0, 0))
    kp = jnp.pad(k, pad).reshape(B, nc + nb, CHUNK, N_KV_HEADS, HEAD_DIM)
    vp = jnp.pad(v, pad).reshape(B, nc + nb, CHUNK, N_KV_HEADS, HEAD_DIM)
    kb = jnp.concatenate([kp[:, i:i + nc] for i in range(nb + 1)], axis=2)
    vb = jnp.concatenate([vp[:, i:i + nc] for i in range(nb + 1)], axis=2)
    key_pos = jnp.arange(nc)[:, None] * CHUNK - WINDOW + jnp.arange((nb + 1) * CHUNK)[None, :]
    valid = key_pos >= 0
    qb = q.reshape(B, nc, CHUNK, N_KV_HEADS, Q_PER_KV, HEAD_DIM)
    s = jnp.einsum('bnqhgd,bnkhd->bnhgqk', qb.astype(F32), kb.astype(F32)) * (HEAD_DIM ** -0.5)
    s = jnp.where(valid[None, :, None, None, None, :], s, -jnp.inf)
    p = sink_softmax(s, sink)
    o = jnp.einsum('bnhgqk,bnkhd->bnqhgd', p, vb.astype(F32))
    return o.reshape(B, S, N_Q_HEADS * HEAD_DIM)


def swa_sample(q, k, v, cache_k, cache_v, sink):
    B, T = q.shape[0], q.shape[1]
    kf = jnp.concatenate([cache_k.astype(k.dtype), k], axis=1)
    vf = jnp.concatenate([cache_v.astype(v.dtype), v], axis=1)
    qh = q.reshape(B, T, N_KV_HEADS, Q_PER_KV, HEAD_DIM)
    s = jnp.einsum('bqhgd,bkhd->bhgqk', qh.astype(F32), kf.astype(F32)) * (HEAD_DIM ** -0.5)
    p = sink_softmax(s, sink)
    o = jnp.einsum('bhgqk,bkhd->bqhgd', p, vf.astype(F32)).reshape(B, T, N_Q_HEADS * HEAD_DIM)
    n_keep = cache_k.shape[1]
    return o, kf[:, -n_keep:], vf[:, -n_keep:]


def even_mixer(h, pos, w_in, w_out, sinks, ret_g, cache_k=None, cache_v=None, ret_state=None):
    B, T = h.shape[0], h.shape[1]
    z = h @ w_in
    split_at = [int(i) for i in np.cumsum(EVEN_SIZES)[:-1]]
    q, k, v, rq, rk, rv, rg = jnp.split(z, split_at, axis=-1)
    q = q.reshape(B, T, N_Q_HEADS, HEAD_DIM)
    k = k.reshape(B, T, N_KV_HEADS, HEAD_DIM)
    v = v.reshape(B, T, N_KV_HEADS, HEAD_DIM)
    rq = rope(rq.reshape(B, T, N_RET_HEADS, RET_DK), pos)
    rk = rope(rk.reshape(B, T, N_RET_HEADS, RET_DK), pos) * (RET_DK ** -0.5)
    rv = rv.reshape(B, T, N_RET_HEADS, RET_DV).astype(F32)
    sink = sinks.reshape(N_KV_HEADS, Q_PER_KV).astype(F32)
    log_g = ret_log_gamma()
    if cache_k is None:
        attn = swa_prompt(q, k, v, sink)
        new_k, new_v = k[:, -WINDOW:], v[:, -WINDOW:]
        ret, new_state = retention_prompt(rq, rk, rv, log_g)
        new_state = new_state.astype(h.dtype)
    else:
        attn, new_k, new_v = swa_sample(q, k, v, cache_k, cache_v, sink)
        ret, new_state = retention_sample(rq, rk, rv, ret_state, log_g)
        new_state = new_state.astype(ret_state.dtype)
    ret = head_norm(ret, ret_g) * jax.nn.silu(rg.astype(F32))
    mixed = jnp.concatenate([attn.astype(h.dtype), ret.astype(h.dtype)], axis=-1)
    return mixed @ w_out, new_k, new_v, new_state


def spatial_gate(u, v, ws, bs):
    B, T = v.shape[0], v.shape[1]
    L = min(T, GM_CHUNK)
    vc = v.reshape(B, T // L, L, GM_GROUPS, GM_GROUP_DIM)
    w = (ws.astype(F32) * jnp.tril(jnp.ones((GM_CHUNK, GM_CHUNK), F32)))[:, :L, :L]
    mixed = jnp.einsum('gij,bnjgc->bnigc', w, vc) + bs[:, :L].astype(F32).T[None, None, :, :, None]
    return u.astype(F32) * mixed.reshape(B, T, GM_WIDTH)


def odd_mixer(h, w_in, w_out, ln_g, ln_b, ws, bs):
    uv = jax.nn.gelu(h @ w_in, approximate=True)
    u, v = jnp.split(uv, 2, axis=-1)
    vn = layer_norm(v, ln_g, ln_b)
    y = spatial_gate(u, vn, ws, bs).astype(h.dtype) @ w_out
    return y, vn.astype(h.dtype)


def conv_ffn(x, w_up, conv_w, conv_b, w_down, conv_state):
    T = x.shape[1]
    h = x @ w_up
    hp = jnp.concatenate([conv_state.astype(h.dtype), h], axis=1)
    hc = conv_b + hp[:, 0:T] * conv_w[0]
    for i in range(1, CONV_W):
        hc = hc + hp[:, i:i + T] * conv_w[i]
    a, g = jnp.split(hc, 2, axis=-1)
    y = (jax.nn.gelu(g, approximate=True) * a) @ w_down
    return y, hp[:, T:]


def setup_inputs(seed: int = 0) -> dict:
    key = jax.random.key(seed)
    ks = jax.random.split(key, 24)

    def nrm(k, shape, scale):
        return jax.random.normal(k, shape, F32) * scale

    win_cache = min(WINDOW, PAST_LEN)
    return {
        'x_prompt': nrm(ks[0], (BATCH, SEQ, D_MODEL), 1.0),
        'x_sample': nrm(ks[1], (DEC_BATCH, DEC_SEQ, D_MODEL), 1.0),
        'cache_swa_k': nrm(ks[2], (N_EVEN, DEC_BATCH, win_cache, N_KV_HEADS, HEAD_DIM), 1.0),
        'cache_swa_v': nrm(ks[3], (N_EVEN, DEC_BATCH, win_cache, N_KV_HEADS, HEAD_DIM), 1.0),
        'state_ret': nrm(ks[4], (N_EVEN, DEC_BATCH, N_RET_HEADS, RET_DK, RET_DV), 1.0),
        'state_ffn_conv': nrm(ks[5], (DEPTH, DEC_BATCH, CONV_W - 1, 2 * D_FF), 1.0),
        'norm_g': 1.0 + nrm(ks[6], (DEPTH, 4, D_MODEL), 0.02),
        'w_in_even': nrm(ks[7], (N_EVEN, D_MODEL, EVEN_IN), D_MODEL ** -0.5),
        'w_out_even': nrm(ks[8], (N_EVEN, EVEN_MIX, D_MODEL), EVEN_MIX ** -0.5),
        'attn_sinks': nrm(ks[9], (N_EVEN, N_Q_HEADS), 1.0),
        'ret_norm_g': 1.0 + nrm(ks[10], (N_EVEN, N_RET_HEADS * RET_DV), 0.02),
        'w_in_odd': nrm(ks[11], (N_ODD, D_MODEL, 2 * GM_WIDTH), D_MODEL ** -0.5),
        'w_out_odd': nrm(ks[12], (N_ODD, GM_WIDTH, D_MODEL), GM_WIDTH ** -0.5),
        'gm_ln_g': 1.0 + nrm(ks[13], (N_ODD, GM_WIDTH), 0.02),
        'gm_ln_b': nrm(ks[14], (N_ODD, GM_WIDTH), 0.02),
        'gm_ws': nrm(ks[15], (N_ODD, GM_GROUPS, GM_CHUNK, GM_CHUNK), GM_CHUNK ** -0.5),
        'gm_bs': 1.0 + nrm(ks[16], (N_ODD, GM_GROUPS, GM_CHUNK), 0.1),
        'ffn_w_up': nrm(ks[17], (DEPTH, D_MODEL, 2 * D_FF), D_MODEL ** -0.5),
        'ffn_conv_w': nrm(ks[18], (DEPTH, CONV_W, 2 * D_FF), CONV_W ** -0.5),
        'ffn_conv_b': nrm(ks[19], (DEPTH, 2 * D_FF), 0.02),
        'ffn_w_down': nrm(ks[20], (DEPTH, D_FF, D_MODEL), D_FF ** -0.5),
    }


def reference(x_prompt, x_sample, cache_swa_k, cache_swa_v, state_ret, state_ffn_conv,
              norm_g, w_in_even, w_out_even, attn_sinks, ret_norm_g,
              w_in_odd, w_out_odd, gm_ln_g, gm_ln_b, gm_ws, gm_bs,
              ffn_w_up, ffn_conv_w, ffn_conv_b, ffn_w_down):
    pos_p = jnp.arange(x_prompt.shape[1])
    pos_s = PAST_LEN + jnp.arange(x_sample.shape[1])
    hp, hs = x_prompt, x_sample
    kp_l, vp_l, rp_l, cp_l = [], [], [], []
    ks_l, vs_l, rs_l, cs_l, gv_l = [], [], [], [], []
    for layer in range(DEPTH):
        g = norm_g[layer]
        if layer % 2 == 0:
            e = layer // 2
            mp, k_p, v_p, r_p = even_mixer(rms_norm(hp, g[0]), pos_p, w_in_even[e], w_out_even[e],
                                           attn_sinks[e], ret_norm_g[e])
            ms, k_s, v_s, r_s = even_mixer(rms_norm(hs, g[0]), pos_s, w_in_even[e], w_out_even[e],
                                           attn_sinks[e], ret_norm_g[e],
                                           cache_swa_k[e], cache_swa_v[e], state_ret[e])
            kp_l.append(k_p); vp_l.append(v_p); rp_l.append(r_p)
            ks_l.append(k_s); vs_l.append(v_s); rs_l.append(r_s)
        else:
            o = layer // 2
            mp, _ = odd_mixer(rms_norm(hp, g[0]), w_in_odd[o], w_out_odd[o], gm_ln_g[o], gm_ln_b[o],
                              gm_ws[o], gm_bs[o])
            ms, gv_s = odd_mixer(rms_norm(hs, g[0]), w_in_odd[o], w_out_odd[o], gm_ln_g[o], gm_ln_b[o],
                                 gm_ws[o], gm_bs[o])
            gv_l.append(gv_s)
        hp = hp + rms_norm(mp, g[1])
        hs = hs + rms_norm(ms, g[1])
        zero_state = jnp.zeros((hp.shape[0], CONV_W - 1, 2 * D_FF), hp.dtype)
        fp, c_p = conv_ffn(rms_norm(hp, g[2]), ffn_w_up[layer], ffn_conv_w[layer], ffn_conv_b[layer],
                           ffn_w_down[layer], zero_state)
        fs, c_s = conv_ffn(rms_norm(hs, g[2]), ffn_w_up[layer], ffn_conv_w[layer], ffn_conv_b[layer],
                           ffn_w_down[layer], state_ffn_conv[layer])
        cp_l.append(c_p); cs_l.append(c_s)
        hp = hp + rms_norm(fp, g[3])
        hs = hs + rms_norm(fs, g[3])
    new_swa_k_prompt = jnp.stack(kp_l)
    new_swa_v_prompt = jnp.stack(vp_l)
    new_ret_prompt = jnp.stack(rp_l)
    new_conv_prompt = jnp.stack(cp_l)
    new_swa_k_sample = jnp.stack(ks_l)
    new_swa_v_sample = jnp.stack(vs_l)
    new_ret_sample = jnp.stack(rs_l)
    new_conv_sample = jnp.stack(cs_l)
    new_gmlp_v_sample = jnp.stack(gv_l)
    return (hp, hs, new_swa_k_prompt, new_swa_v_prompt, new_ret_prompt, new_conv_prompt,
            new_swa_k_sample, new_swa_v_sample, new_ret_sample, new_conv_sample, new_gmlp_v_sample)
```

```cpp
#include <hip/hip_runtime.h>
#include <hip/hip_cooperative_groups.h>
#include <cstdio>
#include <cstdint>
namespace cg = cooperative_groups;
#ifndef ONE_LAUNCH
#define ONE_LAUNCH 0
#endif
namespace pg8 {
#define PG8_LAS __attribute__((address_space(3)))
typedef unsigned short bf16_t;
typedef short bf16x8 __attribute__((ext_vector_type(8)));
typedef float f32x4 __attribute__((ext_vector_type(4)));
typedef unsigned u32x4 __attribute__((ext_vector_type(4)));
constexpr int BM = 256, BK = 64, HALF = 128, HTB = HALF * BK * 2  , STAGE_BYTES = 8 * HTB, NXCD = 8, WGM = 8;

__host__ __device__ __forceinline__ int lds_byte(int r, int c) { const int st = (r >> 4) * 2 + (c >> 5), rr = r & 15, cc = c & 31, ob = rr * 64 + cc * 2; return st * 1024 + (ob ^ (((ob >> 9) & 1) << 5)); }
__host__ __device__ __forceinline__ void stage_rc(int b, int& R, int& C) { const int st = b / 1024, sb = b % 1024, swz = sb ^ (((sb >> 9) & 1) << 5); R = (st >> 1) * 16 + swz / 64; C = (st & 1) * 32 + (swz % 64) / 2; }
__host__ __device__ __forceinline__ int perm32(int rho) { const int n = rho >> 4, i = rho & 15; return 8 * (i >> 2) + 4 * n + (i & 3); }

struct Unit { int pm, pn; };
struct Gemm { const bf16_t* A; const bf16_t* Bt; int M, N, K; };

struct StaticOrder {
    int nM, nN, nwg, G, c;
    __host__ __device__ void init(int M, int N, int G_, int c_) { nM = M / BM; nN = N / BM; nwg = nM * nN; G = G_; c = c_; }
    __host__ __device__ bool next(int i, Unit& u) const {
        const long L = (long)i * G + c; if (L >= nwg) return false;
        int wgid = (int)L; { const int q = nwg / NXCD, r = nwg % NXCD, xcd = wgid % NXCD, off = wgid / NXCD; wgid = (xcd < r ? xcd * (q + 1) : r * (q + 1) + (xcd - r) * q) + off; }
        const int nig = WGM * nN, gid = wgid / nig, fm = gid * WGM, gsz = (nM - fm) < WGM ? (nM - fm) : WGM;
        u.pm = fm + ((wgid % nig) % gsz); u.pn = (wgid % nig) / gsz; return true;
    }
    __device__ __forceinline__ void a_ready(const Unit&) const {}
    __device__ __forceinline__ void done(const Unit&) const {}
};

__device__ __forceinline__ unsigned cvt_pk_bf16(float lo, float hi) { unsigned r; asm volatile("v_cvt_pk_bf16_f32 %0, %1, %2" : "=v"(r) : "v"(lo), "v"(hi)); return r; }
typedef float f32x2 __attribute__((ext_vector_type(2)));
__device__ __forceinline__ float gelu_tanh(float x) { const float u = 0.7978845608f * (x + 0.044715f * x * x * x); return x / (1.f + __expf(-2.f * u)); }
struct EpiBf16 {
    static constexpr bool PERM = true, AFTER_DRAIN = false;
    bf16_t* O; int ldc;
    __device__ __forceinline__ void operator()(const f32x4 (&acc)[2][2][4][2], const Unit& u, int wr, int wc, int fr, int fq) const {
        const int row0 = u.pm * BM + wr * 64 + fr, col0 = u.pn * BM + wc * 32 + 8 * fq;
#pragma unroll
        for (int ai = 0; ai < 2; ++ai)
#pragma unroll
            for (int m = 0; m < 4; ++m) { bf16_t* rowp = O + (size_t)(row0 + ai * HALF + m * 16) * ldc + col0;
#pragma unroll
                for (int bj = 0; bj < 2; ++bj) { const f32x4 v0 = acc[ai][bj][m][0], v1 = acc[ai][bj][m][1];
                    u32x4 w; w.x = cvt_pk_bf16(v0[0], v0[1]); w.y = cvt_pk_bf16(v0[2], v0[3]); w.z = cvt_pk_bf16(v1[0], v1[1]); w.w = cvt_pk_bf16(v1[2], v1[3]);
                    *(u32x4*)(rowp + bj * HALF) = w; } }
    }
};
struct EpiUp {
    static constexpr bool PERM = true, AFTER_DRAIN = false;
    bf16_t* O; int ldc; float* cp; float* cs;
    __device__ __forceinline__ void operator()(const f32x4 (&acc)[2][2][4][2], const Unit& u, int wr, int wc, int fr, int fq) const {
        const int row0 = u.pm * BM + wr * 64 + fr, col0 = u.pn * BM + wc * 32 + 8 * fq;
#pragma unroll
        for (int ai = 0; ai < 2; ++ai)
#pragma unroll
            for (int m = 0; m < 4; ++m) { const int row = row0 + ai * HALF + m * 16; bf16_t* rowp = O + (size_t)row * ldc + col0;
                float* so = nullptr;
                if (row < 8192) { const int t = row & 4095; if (t >= 4094) so = cp + (size_t)((row >> 12) * 2 + (t - 4094)) * ldc + col0; }
                else { const int rs = row - 8192, t = rs & 31; if (t >= 30) so = cs + (size_t)((rs >> 5) * 2 + (t - 30)) * ldc + col0; }
#pragma unroll
                for (int bj = 0; bj < 2; ++bj) { const f32x4 v0 = acc[ai][bj][m][0], v1 = acc[ai][bj][m][1];
                    u32x4 w; w.x = cvt_pk_bf16(v0[0], v0[1]); w.y = cvt_pk_bf16(v0[2], v0[3]); w.z = cvt_pk_bf16(v1[0], v1[1]); w.w = cvt_pk_bf16(v1[2], v1[3]);
                    *(u32x4*)(rowp + bj * HALF) = w;
                    if (so) { *(f32x4*)(so + bj * HALF) = v0; *(f32x4*)(so + bj * HALF + 4) = v1; } } }
    }
};
struct EpiF32 {
    static constexpr bool PERM = false, AFTER_DRAIN = false;
    float* O; int ldc;
    __device__ __forceinline__ void operator()(const f32x4 (&acc)[2][2][4][2], const Unit& u, int wr, int wc, int fr, int fq) const {
        const int row0 = u.pm * BM + wr * 64 + fr, col0 = u.pn * BM + wc * 32 + 4 * fq;
#pragma unroll
        for (int ai = 0; ai < 2; ++ai)
#pragma unroll
            for (int m = 0; m < 4; ++m) { float* rowp = O + (size_t)(row0 + ai * HALF + m * 16) * ldc + col0;
#pragma unroll
                for (int bj = 0; bj < 2; ++bj)
#pragma unroll
                    for (int n = 0; n < 2; ++n) *(f32x4*)(rowp + bj * HALF + n * 16) = acc[ai][bj][m][n]; }
    }
};
struct EpiGeluStats {
    static constexpr bool PERM = true, AFTER_DRAIN = false;
    bf16_t* O; int ldc; float* stats; int vcol0;
    __device__ __forceinline__ void operator()(const f32x4 (&acc)[2][2][4][2], const Unit& u, int wr, int wc, int fr, int fq) const {
        const int row0 = u.pm * BM + wr * 64 + fr, col0 = u.pn * BM + wc * 32 + 8 * fq;
        const bool isv = u.pn * BM >= vcol0;
#pragma unroll
        for (int ai = 0; ai < 2; ++ai)
#pragma unroll
            for (int m = 0; m < 4; ++m) { const int row = row0 + ai * HALF + m * 16; bf16_t* rowp = O + (size_t)row * ldc + col0;
                float s = 0.f, q = 0.f;
#pragma unroll
                for (int bj = 0; bj < 2; ++bj) { f32x4 v0 = acc[ai][bj][m][0], v1 = acc[ai][bj][m][1];
#pragma unroll
                    for (int e = 0; e < 4; ++e) { v0[e] = gelu_tanh(v0[e]); v1[e] = gelu_tanh(v1[e]); s += v0[e] + v1[e]; q += v0[e] * v0[e] + v1[e] * v1[e]; }
                    u32x4 w; w.x = cvt_pk_bf16(v0[0], v0[1]); w.y = cvt_pk_bf16(v0[2], v0[3]); w.z = cvt_pk_bf16(v1[0], v1[1]); w.w = cvt_pk_bf16(v1[2], v1[3]);
                    *(u32x4*)(rowp + bj * HALF) = w; }
                if (isv) { s += __shfl_xor(s, 16); s += __shfl_xor(s, 32); q += __shfl_xor(q, 16); q += __shfl_xor(q, 32);
                    if (fq == 0) { atomicAdd(stats + 2 * row, s); atomicAdd(stats + 2 * row + 1, q); } } }
    }
};
template <class Epi, class Sched, bool ALIGN_EPI = false, bool SP2 = false>
__device__ __forceinline__ void gemm_phase(PG8_LAS unsigned char* lds, const Gemm g, const Sched& S, const Epi& E) {
    int tid_ = threadIdx.x; asm volatile("" : "+v"(tid_)); const int tid = tid_, wid = __builtin_amdgcn_readfirstlane(tid >> 6), lane = tid & 63, wr = wid >> 2, wc = wid & 3, fr = lane & 15, fq = lane >> 4;
    const int K = g.K, nt = K / BK;
    unsigned voffA[2], voffB[2];
#pragma unroll
    for (int i = 0; i < 2; ++i) { int R, C; stage_rc(tid * 16 + i * 8192, R, C); const int Rb = Epi::PERM ? ((R & ~31) + perm32(R & 31)) : R;
        voffA[i] = (unsigned)(R * K + C) * 2u; voffB[i] = (unsigned)(Rb * K + C) * 2u; }
    const size_t kstep = (size_t)(BK * 2);
    const size_t hstep = (size_t)HALF * K * 2;
    const size_t tstep = 2 * hstep;
    const unsigned ldsw = (unsigned)wid * 1024u;
    const int aoff = lds_byte(wr * 64 + fr, fq * 8), boff = lds_byte(wc * 32 + fr, fq * 8);
#define PG8_SA(b, h) (((b) * 2 + (h)) * HTB)
#define PG8_SB(b, h) ((4 + (b) * 2 + (h)) * HTB)
#define PG8_STAGE(bufoff, gbase, voff) do { _Pragma("unroll") for (int _i = 0; _i < 2; ++_i) \
        __builtin_amdgcn_global_load_lds((const unsigned*)((const char*)(gbase) + (voff)[_i]), (PG8_LAS unsigned*)(lds + (bufoff) + ldsw + _i * 8192), 16, 0, 0); } while (0)
#define PG8_LDA(dst, b, h) do { _Pragma("unroll") for (int m = 0; m < 4; ++m) _Pragma("unroll") for (int k = 0; k < 2; ++k) dst[m][k] = *(const PG8_LAS bf16x8*)(lds + PG8_SA(b, h) + aoff + m * 2048 + k * 1024); } while (0)
#define PG8_LDB(dst, b, h) do { _Pragma("unroll") for (int n = 0; n < 2; ++n) _Pragma("unroll") for (int k = 0; k < 2; ++k) dst[n][k] = *(const PG8_LAS bf16x8*)(lds + PG8_SB(b, h) + boff + n * 2048 + k * 1024); } while (0)
#define PG8_MMA(ai, bj, At, Bt) do { __builtin_amdgcn_s_setprio(1); _Pragma("unroll") for (int m = 0; m < 4; ++m) _Pragma("unroll") for (int n = 0; n < 2; ++n) _Pragma("unroll") for (int k = 0; k < 2; ++k) \
        acc[ai][bj][m][n] = __builtin_amdgcn_mfma_f32_16x16x32_bf16(Bt[n][k], At[m][k], acc[ai][bj][m][n], 0, 0, 0); __builtin_amdgcn_s_setprio(0); } while (0)
#define PG8_WAIT_V(n) asm volatile("s_waitcnt vmcnt(" #n ")" ::: "memory")
#define PG8_WAIT_L(n) asm volatile("s_waitcnt lgkmcnt(" #n ")" ::: "memory")
#define PG8_BAR __builtin_amdgcn_s_barrier()
#define PG8_SCHED __builtin_amdgcn_sched_barrier(0)
    Unit cur, nxt; int ui = 0;
    if (!S.next(0, cur)) return;
    f32x4 acc[2][2][4][2];
#pragma unroll
    for (int a = 0; a < 2; ++a)
#pragma unroll
        for (int b = 0; b < 2; ++b)
#pragma unroll
            for (int m = 0; m < 4; ++m)
#pragma unroll
                for (int n = 0; n < 2; ++n) acc[a][b][m][n] = (f32x4){0.f, 0.f, 0.f, 0.f};
    bf16x8 At[4][2], B0[2][2], B1[2][2];
    const char* cA = (const char*)g.A + (size_t)cur.pm * tstep; const char* cB = (const char*)g.Bt + (size_t)cur.pn * tstep;
    S.a_ready(cur);
    if constexpr (SP2) {
        PG8_STAGE(PG8_SB(0, 0), cB, voffB); PG8_STAGE(PG8_SB(0, 1), cB + hstep, voffB); PG8_STAGE(PG8_SA(0, 0), cA, voffA); PG8_STAGE(PG8_SA(0, 1), cA + hstep, voffA);
        if (wr == 1) PG8_BAR;
        PG8_WAIT_V(2); PG8_BAR;
        PG8_STAGE(PG8_SB(1, 0), cB + kstep, voffB); PG8_STAGE(PG8_SA(1, 0), cA + kstep, voffA); PG8_STAGE(PG8_SB(1, 1), cB + hstep + kstep, voffB);
        PG8_WAIT_V(6); PG8_BAR;
    } else {
        PG8_STAGE(PG8_SB(0, 0), cB, voffB); PG8_STAGE(PG8_SA(0, 0), cA, voffA); PG8_STAGE(PG8_SB(0, 1), cB + hstep, voffB); PG8_STAGE(PG8_SA(0, 1), cA + hstep, voffA);
        if (wr == 1) PG8_BAR;
        PG8_WAIT_V(4); PG8_BAR;
        PG8_STAGE(PG8_SB(1, 0), cB + kstep, voffB); PG8_STAGE(PG8_SA(1, 0), cA + kstep, voffA); PG8_STAGE(PG8_SB(1, 1), cB + hstep + kstep, voffB);
        PG8_WAIT_V(6); PG8_BAR;
    }
    for (;;) {
        const bool has_next = S.next(ui + 1, nxt);
        const char* nA = has_next ? (const char*)g.A + (size_t)nxt.pm * tstep : cA; const char* nB = has_next ? (const char*)g.Bt + (size_t)nxt.pn * tstep : cB;
        for (int t = 0; t < nt; t += 2) {
            const bool last = (t == nt - 2);
            const char* a1 = cA + (size_t)(t + 1) * kstep;
            const char* a2 = last ? nA : cA + (size_t)(t + 2) * kstep; const char* b2 = last ? nB : cB + (size_t)(t + 2) * kstep;
            const char* a3 = a2 + kstep; const char* b3 = b2 + kstep;
            if (last && has_next) S.a_ready(nxt);
            if constexpr (SP2) {
            PG8_LDB(B0, 0, 0); PG8_LDB(B1, 0, 1); PG8_SCHED; PG8_LDA(At, 0, 0); PG8_STAGE(PG8_SA(1, 1), a1 + hstep, voffA);
            PG8_WAIT_V(8); PG8_WAIT_L(0); PG8_BAR; PG8_MMA(0, 0, At, B0); PG8_MMA(0, 1, At, B1); PG8_BAR; PG8_SCHED;
            PG8_LDA(At, 0, 1); PG8_STAGE(PG8_SB(0, 0), b2, voffB); PG8_STAGE(PG8_SB(0, 1), b2 + hstep, voffB); PG8_STAGE(PG8_SA(0, 0), a2, voffA);
            PG8_WAIT_V(8); PG8_WAIT_L(0); PG8_BAR; PG8_MMA(1, 0, At, B0); PG8_MMA(1, 1, At, B1); PG8_BAR; PG8_SCHED;
            PG8_LDB(B0, 1, 0); PG8_LDB(B1, 1, 1); PG8_SCHED; PG8_LDA(At, 1, 0); PG8_STAGE(PG8_SA(0, 1), a2 + hstep, voffA);
            PG8_WAIT_V(8); PG8_WAIT_L(0); PG8_BAR; PG8_MMA(0, 0, At, B0); PG8_MMA(0, 1, At, B1); PG8_BAR; PG8_SCHED;
            PG8_LDA(At, 1, 1); PG8_STAGE(PG8_SB(1, 0), b3, voffB); PG8_STAGE(PG8_SB(1, 1), b3 + hstep, voffB); PG8_STAGE(PG8_SA(1, 0), a3, voffA);
            PG8_WAIT_V(8); PG8_WAIT_L(0); PG8_BAR; PG8_MMA(1, 0, At, B0); PG8_MMA(1, 1, At, B1); PG8_BAR; PG8_SCHED;
            } else {
            PG8_LDB(B0, 0, 0); PG8_SCHED; PG8_LDA(At, 0, 0); PG8_STAGE(PG8_SA(1, 1), a1 + hstep, voffA);
            PG8_WAIT_L(8); PG8_BAR; PG8_WAIT_L(0); PG8_MMA(0, 0, At, B0); PG8_BAR; PG8_SCHED;
            PG8_LDB(B1, 0, 1); PG8_STAGE(PG8_SB(0, 0), b2, voffB);
            PG8_BAR; PG8_WAIT_L(0); PG8_MMA(0, 1, At, B1); PG8_BAR;
            PG8_LDA(At, 0, 1); PG8_STAGE(PG8_SA(0, 0), a2, voffA);
            PG8_BAR; PG8_WAIT_L(0); PG8_MMA(1, 0, At, B0); PG8_BAR; PG8_SCHED;
            PG8_STAGE(PG8_SB(0, 1), b2 + hstep, voffB);
            PG8_WAIT_V(6); PG8_BAR; PG8_MMA(1, 1, At, B1); PG8_BAR;
            PG8_LDB(B0, 1, 0); PG8_SCHED; PG8_LDA(At, 1, 0); PG8_STAGE(PG8_SA(0, 1), a2 + hstep, voffA);
            PG8_WAIT_L(8); PG8_BAR; PG8_WAIT_L(0); PG8_MMA(0, 0, At, B0); PG8_BAR; PG8_SCHED;
            PG8_LDB(B1, 1, 1); PG8_STAGE(PG8_SB(1, 0), b3, voffB);
            PG8_BAR; PG8_WAIT_L(0); PG8_MMA(0, 1, At, B1); PG8_BAR;
            PG8_LDA(At, 1, 1); PG8_STAGE(PG8_SA(1, 0), a3, voffA);
            PG8_BAR; PG8_WAIT_L(0); PG8_MMA(1, 0, At, B0); PG8_BAR; PG8_SCHED;
            PG8_STAGE(PG8_SB(1, 1), b3 + hstep, voffB);
            PG8_WAIT_V(6); PG8_BAR; PG8_MMA(1, 1, At, B1); PG8_BAR;
            }
        }
        if constexpr (ALIGN_EPI) { if (wr == 0) PG8_BAR; }
        if constexpr (!Epi::AFTER_DRAIN) { E(acc, cur, wr, wc, fr, fq); S.done(cur); }
        if (!has_next) break;
#pragma unroll
        for (int a = 0; a < 2; ++a)
#pragma unroll
            for (int b = 0; b < 2; ++b)
#pragma unroll
                for (int m = 0; m < 4; ++m)
#pragma unroll
                    for (int n = 0; n < 2; ++n) acc[a][b][m][n] = (f32x4){0.f, 0.f, 0.f, 0.f};
        cur = nxt; cA = nA; cB = nB; ++ui;
        if constexpr (ALIGN_EPI) { if (wr == 1) PG8_BAR; }
    }
    PG8_WAIT_V(0);
    if constexpr (!ALIGN_EPI) { if (wr == 0) PG8_BAR; }
    PG8_BAR;
    if constexpr (Epi::AFTER_DRAIN) { E.fused(acc, cur, wr, wc, fr, fq, lds, wid, lane); S.done(cur); }
#undef PG8_SA
#undef PG8_SB
#undef PG8_STAGE
#undef PG8_LDA
#undef PG8_LDB
#undef PG8_MMA
#undef PG8_WAIT_V
#undef PG8_WAIT_L
#undef PG8_BAR
#undef PG8_SCHED
}
}
#define DI __device__ __forceinline__
#define LAS __attribute__((address_space(3)))
typedef unsigned short bf16;
typedef float f32x4 __attribute__((ext_vector_type(4)));
typedef short bf16x8 __attribute__((ext_vector_type(8)));
typedef short s16x4 __attribute__((ext_vector_type(4)));
typedef unsigned u32x4 __attribute__((ext_vector_type(4)));
typedef unsigned u32x2 __attribute__((ext_vector_type(2)));
#define MFMA16(a, b, c) __builtin_amdgcn_mfma_f32_16x16x32_bf16((a), (b), (c), 0, 0, 0)

constexpr int DM = 2048, MPR = 8192, M = 8704, EVEN_IN = 5632, DFF = 5632, DFF2 = 11264;
constexpr int ZQ = 0, ZK = 1024, ZV = 1280, ZRQ = 1536, ZRK = 2560, ZRV = 3584, ZRG = 4608;
constexpr float EPS = 1e-6f;
constexpr size_t O_Y = 0, O_KP = 17825792, O_VP = 17891328, O_RP = 17956864, O_CP = 18219008, O_KS = 18309120, O_VS = 18833408,
                 O_RS = 19357696, O_CS = 21454848, O_GV = 22175744, O_END = 23224320;
constexpr size_t MiB = 1u << 20;
constexpr size_t WS_CTL = 0, CTL_BYTES = 1 * MiB, WS_STATS = 65536;
constexpr size_t WS_COS = 1 * MiB, WS_SIN = 2 * MiB;
constexpr size_t WS_WINE = 3 * MiB, WS_WOUTE = 25 * MiB, WS_WINO = 33 * MiB, WS_WOUTO = 49 * MiB, WS_WUP = 57 * MiB, WS_WDN = 145 * MiB;
constexpr size_t WS_XN = 189 * MiB, WS_MIX = 223 * MiB, WS_MPB = 257 * MiB, WS_ACT = 325 * MiB, WS_A = 419 * MiB, WS_END = 609 * MiB;
constexpr size_t WS_Z = WS_A, WS_KV = WS_A + 94 * MiB, WS_ST = WS_A + 158 * MiB, WS_HRAW = WS_A, WS_UV = WS_A;
constexpr int LDS_BYTES = 131072 + 1024;

enum { PH_PRO = 0, PH_WIN_E, PH_MIXA, PH_SCAN, PH_MIXC, PH_WOUT_E, PH_ROWA0, PH_UP0, PH_CONV0, PH_DOWN0, PH_ROWB0,
       PH_WIN_O, PH_SGATE, PH_WOUT_O, PH_ROWA1, PH_UP1, PH_CONV1, PH_DOWN1, PH_ROWB1, NPH };

struct Args { const float* in[21]; float* out; unsigned char* ws; int ph_lo, ph_hi; };
enum { I_XP = 0, I_XS, I_CK, I_CV, I_SRET, I_SCONV, I_NORMG, I_WINE, I_WOUTE, I_SINK, I_RETG, I_WINO, I_WOUTO, I_LNG, I_LNB, I_GWS, I_GBS, I_WUP, I_CW, I_CB, I_WDN };

DI unsigned f2bf(float f) { unsigned u = __builtin_bit_cast(unsigned, f); return (u + 0x7fffu + ((u >> 16) & 1u)) >> 16; }
DI unsigned pk2(float lo, float hi) { unsigned r; asm volatile("v_cvt_pk_bf16_f32 %0, %1, %2" : "=v"(r) : "v"(lo), "v"(hi)); return r; }
DI float bflo(unsigned u) { return __builtin_bit_cast(float, u << 16); }
DI float bfhi(unsigned u) { return __builtin_bit_cast(float, u & 0xffff0000u); }
DI float wave_sum(float v) {
#pragma unroll
    for (int o = 1; o < 64; o <<= 1) v += __shfl_xor(v, o);
    return v;
}
DI float dot4(f32x4 a) { return (a.x * a.x + a.y * a.y) + (a.z * a.z + a.w * a.w); }

struct Ctx {
    LAS unsigned char* lds; int tid, lane, wave, l15, quad, bx; Args a;
    bf16 *Z, *XN, *MIX, *ACT, *HRAW, *UV, *STB; float *MPB, *KV, *COS, *SIN, *STATS, *H;
};

DI void transpose_item(const float* W, int K, int N, bf16* WT, LAS float* scr, int item, int lane) {
    const int nblk = N / 32, kb = item / nblk, nb = item % nblk, k0 = 64 * kb, n0 = 32 * nb;
#pragma unroll 8
    for (int i = 0; i < 32; ++i) { const int kk = 2 * i + (lane >> 5); scr[kk * 33 + (lane & 31)] = W[(size_t)(k0 + kk) * N + n0 + (lane & 31)]; }
    asm volatile("s_waitcnt lgkmcnt(0)" ::: "memory");
    const int c = lane & 7;
#pragma unroll
    for (int j = 0; j < 4; ++j) { const int n = (lane >> 3) + 8 * j; const LAS float* s = scr + (8 * c) * 33 + n;
        u32x4 o; o.x = pk2(s[0 * 33], s[1 * 33]); o.y = pk2(s[2 * 33], s[3 * 33]); o.z = pk2(s[4 * 33], s[5 * 33]); o.w = pk2(s[6 * 33], s[7 * 33]);
        *(u32x4*)(WT + (size_t)(n0 + n) * K + k0 + 8 * c) = o; }
    asm volatile("s_waitcnt lgkmcnt(0)" ::: "memory");
}
DI void rms_row_to_bf16(const float* xrow, const float* g, bf16* orow, int lane) {
    f32x4 v[8]; float s = 0.f;
#pragma unroll
    for (int j = 0; j < 8; ++j) { v[j] = ((const f32x4*)xrow)[lane + 64 * j]; s += dot4(v[j]); }
    const float r = 1.f / sqrtf(wave_sum(s) * (1.f / DM) + EPS);
#pragma unroll
    for (int j = 0; j < 8; ++j) { const f32x4 gg = ((const f32x4*)g)[lane + 64 * j]; const f32x4 o = v[j] * r * gg;
        u32x2 w; w.x = pk2(o.x, o.y); w.y = pk2(o.z, o.w); ((u32x2*)orow)[lane + 64 * j] = w; }
}
DI void prologue(Ctx& c) {
    LAS float* scr = (LAS float*)(c.lds + c.wave * 16384);
    const int gw = c.bx * 8 + c.wave, NGW = gridDim.x * 8;
    unsigned char* ws = c.a.ws;
    constexpr int I0 = 32 * 176, I1 = 32 * 64, I2 = 32 * 128, I3 = 32 * 64, I4 = 32 * 352, I5 = 88 * 64;
    constexpr int NIT = I0 + I1 + I2 + I3 + 2 * I4 + 2 * I5;
    for (int it = gw; it < NIT; it += NGW) {
        int r = it;
        if (r < I0) { transpose_item(c.a.in[I_WINE], 2048, 5632, (bf16*)(ws + WS_WINE), scr, r, c.lane); continue; } r -= I0;
        if (r < I1) { transpose_item(c.a.in[I_WOUTE], 2048, 2048, (bf16*)(ws + WS_WOUTE), scr, r, c.lane); continue; } r -= I1;
        if (r < I2) { transpose_item(c.a.in[I_WINO], 2048, 4096, (bf16*)(ws + WS_WINO), scr, r, c.lane); continue; } r -= I2;
        if (r < I3) { transpose_item(c.a.in[I_WOUTO], 2048, 2048, (bf16*)(ws + WS_WOUTO), scr, r, c.lane); continue; } r -= I3;
        if (r < 2 * I4) { const int L = r / I4; transpose_item(c.a.in[I_WUP] + (size_t)L * 2048 * 11264, 2048, 11264, (bf16*)(ws + WS_WUP) + (size_t)L * 2048 * 11264, scr, r % I4, c.lane); continue; } r -= 2 * I4;
        { const int L = r / I5; transpose_item(c.a.in[I_WDN] + (size_t)L * 5632 * 2048, 5632, 2048, (bf16*)(ws + WS_WDN) + (size_t)L * 5632 * 2048, scr, r % I5, c.lane); }
    }
    const float* g0 = c.a.in[I_NORMG];
    for (int m = gw; m < M; m += NGW) {
        const float* xr = m < MPR ? c.a.in[I_XP] + (size_t)m * DM : c.a.in[I_XS] + (size_t)(m - MPR) * DM;
        rms_row_to_bf16(xr, g0, c.XN + (size_t)m * DM, c.lane);
    }
    const int gt = c.bx * 512 + c.tid, NT = gridDim.x * 512;
    for (int i = gt; i < 4096 * 64; i += NT) { const int pos = i >> 6, d = i & 63;
        const float freq = 1.0f / powf(10000.0f, (float)d * (1.0f / 64.0f)); const float ang = (float)pos * freq;
        float sn, cs; sincosf(ang, &sn, &cs); c.COS[i] = cs; c.SIN[i] = sn; }
}

DI u32x4 pack8(const float* p) { const f32x4 a = *(const f32x4*)p, b = *(const f32x4*)(p + 4); u32x4 r; r.x = pk2(a.x, a.y); r.y = pk2(a.z, a.w); r.z = pk2(b.x, b.y); r.w = pk2(b.z, b.w); return r; }
DI void swa_unit(Ctx& c, int u) {
    const int tid = c.tid, w = c.wave, l15 = c.l15, quad = c.quad;
    const bool sample = u >= 512;
    int b, hk, qrow0, krow0 = 0, nkt, ktb;
    if (!sample) { b = u >> 8; const int ch = (u >> 2) & 63; hk = u & 3; qrow0 = b * 4096 + ch * 64; krow0 = qrow0 - 128; nkt = 12; ktb = ch < 2 ? (2 - ch) * 4 : 0; }
    else { const int us = u - 512; b = us >> 2; hk = us & 3; qrow0 = MPR + b * 32; nkt = 10; ktb = 0; }
    LAS bf16* Ks = (LAS bf16*)c.lds;
    LAS bf16* Vt = (LAS bf16*)(c.lds + 192 * 144);
    for (int idx = tid; idx < nkt * 128; idx += 512) {
        const int kk = idx >> 3, seg = idx & 7;
        u32x4 kv = {0u, 0u, 0u, 0u}, vv = {0u, 0u, 0u, 0u};
        if (!sample) { if (kk >= ktb * 16) { const bf16* zr = c.Z + (size_t)(krow0 + kk) * EVEN_IN + hk * 64 + seg * 8; kv = *(const u32x4*)(zr + ZK); vv = *(const u32x4*)(zr + ZV); } }
        else if (kk < 128) { const size_t off = ((size_t)(b * 128 + kk) * 4 + hk) * 64 + seg * 8; kv = pack8(c.a.in[I_CK] + off); vv = pack8(c.a.in[I_CV] + off); }
        else { const bf16* zr = c.Z + (size_t)(qrow0 + kk - 128) * EVEN_IN + hk * 64 + seg * 8; kv = *(const u32x4*)(zr + ZK); vv = *(const u32x4*)(zr + ZV); }
        *(LAS u32x4*)(Ks + kk * 72 + seg * 8) = kv;
#pragma unroll
        for (int k = 0; k < 4; ++k) { Vt[(seg * 8 + 2 * k) * 200 + kk] = (bf16)(vv[k] & 0xffffu); Vt[(seg * 8 + 2 * k + 1) * 200 + kk] = (bf16)(vv[k] >> 16); }
    }
    __syncthreads();
    const int head = hk * 4 + (w >> 1);
    const float sink = c.a.in[I_SINK][head];
    const int nqt = sample ? 1 : 2;
    for (int qt = 0; qt < nqt; ++qt) {
        const int qloc = sample ? (w & 1) * 16 : (w & 1) * 32 + qt * 16;
        const size_t qrow = (size_t)(qrow0 + qloc + l15);
        bf16x8 Qf[2];
#pragma unroll
        for (int s = 0; s < 2; ++s) Qf[s] = *(const bf16x8*)(c.Z + qrow * EVEN_IN + ZQ + head * 64 + s * 32 + quad * 8);
        f32x4 st[12];
        float mx = sink;
#pragma unroll
        for (int kt = 0; kt < 12; ++kt) {
            if (kt >= ktb && kt < nkt) {
                const bf16x8 a0 = *(const LAS bf16x8*)(Ks + (kt * 16 + l15) * 72 + quad * 8), a1 = *(const LAS bf16x8*)(Ks + (kt * 16 + l15) * 72 + 32 + quad * 8);
                f32x4 acc = {0.f, 0.f, 0.f, 0.f}; acc = MFMA16(a0, Qf[0], acc); acc = MFMA16(a1, Qf[1], acc);
                st[kt] = acc * 0.125f;
                mx = fmaxf(mx, fmaxf(fmaxf(st[kt][0], st[kt][1]), fmaxf(st[kt][2], st[kt][3])));
            } else st[kt] = (f32x4){-INFINITY, -INFINITY, -INFINITY, -INFINITY};
        }
        mx = fmaxf(mx, __shfl_xor(mx, 16)); mx = fmaxf(mx, __shfl_xor(mx, 32));
        float sum = 0.f;
#pragma unroll
        for (int kt = 0; kt < 12; ++kt)
#pragma unroll
            for (int e = 0; e < 4; ++e) { const float p = __expf(st[kt][e] - mx); st[kt][e] = p; sum += p; }
        sum += __shfl_xor(sum, 16); sum += __shfl_xor(sum, 32); sum += __expf(sink - mx);
        f32x4 O[4];
#pragma unroll
        for (int dt = 0; dt < 4; ++dt) O[dt] = (f32x4){0.f, 0.f, 0.f, 0.f};
#pragma unroll
        for (int kb = 0; kb < 6; ++kb) {
            if (kb * 2 < nkt && kb * 2 + 1 >= ktb) {
                u32x4 pw; pw.x = pk2(st[2 * kb][0], st[2 * kb][1]); pw.y = pk2(st[2 * kb][2], st[2 * kb][3]); pw.z = pk2(st[2 * kb + 1][0], st[2 * kb + 1][1]); pw.w = pk2(st[2 * kb + 1][2], st[2 * kb + 1][3]);
                const bf16x8 Pf = __builtin_bit_cast(bf16x8, pw);
#pragma unroll
                for (int dt = 0; dt < 4; ++dt) {
                    const s16x4 lo = *(const LAS s16x4*)(Vt + (dt * 16 + l15) * 200 + kb * 32 + quad * 4), hi = *(const LAS s16x4*)(Vt + (dt * 16 + l15) * 200 + kb * 32 + 16 + quad * 4);
                    const bf16x8 Vf = __builtin_shufflevector(lo, hi, 0, 1, 2, 3, 4, 5, 6, 7);
                    O[dt] = MFMA16(Vf, Pf, O[dt]);
                }
            }
        }
        const float inv = 1.f / sum;
#pragma unroll
        for (int dt = 0; dt < 4; ++dt) { const f32x4 o = O[dt] * inv; u32x2 wv; wv.x = pk2(o.x, o.y); wv.y = pk2(o.z, o.w);
            *(u32x2*)(c.MIX + qrow * DM + head * 64 + dt * 16 + quad * 4) = wv; }
    }
    __syncthreads();
}

DI float ret_logg(int h) { return log1pf(-exp2f(-5.0f - (float)h)); }
DI void rope_frags(const bf16* zr  , const float* cosr  , const float* sinr, float scale, float (&f)[4][8]) {
    u32x4 x[4];
#pragma unroll
    for (int s = 0; s < 4; ++s) x[s] = *(const u32x4*)(zr + s * 32);
#pragma unroll
    for (int s2 = 0; s2 < 2; ++s2) {
        float cs[8], sn[8];
        *(f32x4*)&cs[0] = *(const f32x4*)(cosr + s2 * 32); *(f32x4*)&cs[4] = *(const f32x4*)(cosr + s2 * 32 + 4);
        *(f32x4*)&sn[0] = *(const f32x4*)(sinr + s2 * 32); *(f32x4*)&sn[4] = *(const f32x4*)(sinr + s2 * 32 + 4);
#pragma unroll
        for (int k = 0; k < 8; ++k) { const unsigned w1 = x[s2][k >> 1], w2 = x[s2 + 2][k >> 1];
            const float a = (k & 1) ? bfhi(w1) : bflo(w1), bb = (k & 1) ? bfhi(w2) : bflo(w2);
            f[s2][k] = (a * cs[k] - bb * sn[k]) * scale; f[s2 + 2][k] = (bb * cs[k] + a * sn[k]) * scale; }
    }
}
DI bf16x8 packf8(const float (&f)[8], float sc) { u32x4 r; r.x = pk2(f[0] * sc, f[1] * sc); r.y = pk2(f[2] * sc, f[3] * sc); r.z = pk2(f[4] * sc, f[5] * sc); r.w = pk2(f[6] * sc, f[7] * sc); return __builtin_bit_cast(bf16x8, r); }

DI void retkv_unit(Ctx& c, int u) {
    const int tid = c.tid, w = c.wave, l15 = c.l15, quad = c.quad;
    const bool sample = u >= 1024;
    int b, n = 0, h, row0, pos0, T;
    if (!sample) { b = u >> 9; n = (u >> 3) & 63; h = u & 7; row0 = b * 4096 + n * 64; pos0 = n * 64; T = 64; }
    else { const int us = u - 1024; b = us >> 3; h = us & 7; row0 = MPR + b * 32; pos0 = 1024; T = 32; }
    const float logg = ret_logg(h);
    LAS bf16* KT = (LAS bf16*)c.lds;
    LAS bf16* VT = (LAS bf16*)(c.lds + 128 * 144);
    for (int idx = tid; idx < T * 8; idx += 512) {
        const int j = idx >> 3, d0 = (idx & 7) * 8;
        const bf16* zr = c.Z + (size_t)(row0 + j) * EVEN_IN + ZRK + h * 128 + d0;
        const u32x4 x1 = *(const u32x4*)zr, x2 = *(const u32x4*)(zr + 64);
        const float* cr = c.COS + (size_t)(pos0 + j) * 64 + d0; const float* sr = c.SIN + (size_t)(pos0 + j) * 64 + d0;
        float cs[8], sn[8];
        *(f32x4*)&cs[0] = *(const f32x4*)cr; *(f32x4*)&cs[4] = *(const f32x4*)(cr + 4); *(f32x4*)&sn[0] = *(const f32x4*)sr; *(f32x4*)&sn[4] = *(const f32x4*)(sr + 4);
        const float sc = 0.08838834764831845f * __expf(logg * (float)(T - 1 - j));
#pragma unroll
        for (int k = 0; k < 8; ++k) { const unsigned w1 = x1[k >> 1], w2 = x2[k >> 1];
            const float a = (k & 1) ? bfhi(w1) : bflo(w1), bb = (k & 1) ? bfhi(w2) : bflo(w2);
            KT[(d0 + k) * 72 + j] = (bf16)f2bf((a * cs[k] - bb * sn[k]) * sc); KT[(64 + d0 + k) * 72 + j] = (bf16)f2bf((bb * cs[k] + a * sn[k]) * sc); }
    }
    for (int idx = tid; idx < T * 16; idx += 512) {
        const int j = idx >> 4, e0 = (idx & 15) * 8;
        const u32x4 vv = *(const u32x4*)(c.Z + (size_t)(row0 + j) * EVEN_IN + ZRV + h * 128 + e0);
#pragma unroll
        for (int k = 0; k < 4; ++k) { VT[(e0 + 2 * k) * 72 + j] = (bf16)(vv[k] & 0xffffu); VT[(e0 + 2 * k + 1) * 72 + j] = (bf16)(vv[k] >> 16); }
    }
    __syncthreads();
    f32x4 acc[8];
#pragma unroll
    for (int dt = 0; dt < 8; ++dt) acc[dt] = (f32x4){0.f, 0.f, 0.f, 0.f};
#pragma unroll
    for (int s = 0; s < 2; ++s) {
        if (s * 32 < T) {
            const bf16x8 av = *(const LAS bf16x8*)(VT + (w * 16 + l15) * 72 + s * 32 + quad * 8);
#pragma unroll
            for (int dt = 0; dt < 8; ++dt) { const bf16x8 bk = *(const LAS bf16x8*)(KT + (dt * 16 + l15) * 72 + s * 32 + quad * 8); acc[dt] = MFMA16(av, bk, acc[dt]); }
        }
    }
    if (!sample) {
        float* o = c.KV + (size_t)((b * 64 + n) * 8 + h) * 16384;
#pragma unroll
        for (int dt = 0; dt < 8; ++dt)
#pragma unroll
            for (int e = 0; e < 4; ++e) o[(w * 16 + quad * 4 + e) * 128 + dt * 16 + l15] = acc[dt][e];
    } else {
        const float cd = __expf(logg * 32.0f);
        const float* st = c.a.in[I_SRET] + (size_t)(b * 8 + h) * 16384; float* o = c.a.out + O_RS + (size_t)(b * 8 + h) * 16384;
#pragma unroll
        for (int dt = 0; dt < 8; ++dt) { const int off = (dt * 16 + l15) * 128 + w * 16 + quad * 4; *(f32x4*)(o + off) = *(const f32x4*)(st + off) * cd + acc[dt]; }
    }
    __syncthreads();
}
DI void ret_scan(Ctx& c) {
    const int gt = c.bx * 512 + c.tid, NT = gridDim.x * 512;
    for (int i = gt; i < 16 * 8192; i += NT) {
        const int bh = i >> 13, off = (i & 8191) * 2, b = bh >> 3, h = bh & 7;
        const float cd = __expf(ret_logg(h) * 64.0f);
        float s0 = 0.f, s1 = 0.f;
        const float* kv = c.KV + (size_t)(b * 64 * 8 + h) * 16384 + off; bf16* st = c.STB + (size_t)(b * 64 * 8 + h) * 16384 + off;
#pragma unroll 8
        for (int n = 0; n < 64; ++n) { *(unsigned*)(st + (size_t)n * 8 * 16384) = pk2(s0, s1);
            const float2 v = *(const float2*)(kv + (size_t)n * 8 * 16384); s0 = cd * s0 + v.x; s1 = cd * s1 + v.y; }
        const int e = off >> 7, d = off & 127;
        float* o = c.a.out + O_RP + (size_t)bh * 16384; o[d * 128 + e] = s0; o[(d + 1) * 128 + e] = s1;
    }
}
DI void retout_pair(Ctx& c, int pu) {
    const int tid = c.tid, w = c.wave, l15 = c.l15, quad = c.quad, sub = w >> 2, it = w & 3, t256 = tid & 255;
    const bool sample = pu >= 512;
    int b, n = 0, h, row0, pos0, T;
    if (!sample) { const int u = pu * 2 + sub; b = u >> 9; n = (u >> 3) & 63; h = u & 7; row0 = b * 4096 + n * 64; pos0 = n * 64; T = 64; }
    else { const int us = (pu - 512) * 2 + sub; b = us >> 3; h = us & 7; row0 = MPR + b * 32; pos0 = 1024; T = 32; }
    LAS bf16* VT = (LAS bf16*)(c.lds + sub * 53248);
    LAS bf16* ST = VT + 128 * 72;
    for (int idx = t256; idx < T * 16; idx += 256) {
        const int j = idx >> 4, e0 = (idx & 15) * 8;
        const u32x4 vv = *(const u32x4*)(c.Z + (size_t)(row0 + j) * EVEN_IN + ZRV + h * 128 + e0);
#pragma unroll
        for (int k = 0; k < 4; ++k) { VT[(e0 + 2 * k) * 72 + j] = (bf16)(vv[k] & 0xffffu); VT[(e0 + 2 * k + 1) * 72 + j] = (bf16)(vv[k] >> 16); }
    }
    if (!sample) { const bf16* src = c.STB + (size_t)((b * 64 + n) * 8 + h) * 16384;
        for (int idx = t256; idx < 2048; idx += 256) { const int e = idx >> 4, d0 = (idx & 15) * 8; *(LAS u32x4*)(ST + e * 136 + d0) = *(const u32x4*)(src + e * 128 + d0); } }
    else { const float* src = c.a.in[I_SRET] + (size_t)(b * 8 + h) * 16384;
        for (int idx = t256; idx < 4096; idx += 256) { const int d = idx >> 5, e0 = (idx & 31) * 4; const f32x4 v = *(const f32x4*)(src + d * 128 + e0);
#pragma unroll
            for (int k = 0; k < 4; ++k) ST[(e0 + k) * 136 + d] = (bf16)f2bf(v[k]); } }
    __syncthreads();
    if (it * 16 < T) {
        const float logg = ret_logg(h);
        const int i = it * 16 + l15; const size_t rowi = (size_t)(row0 + i);
        bf16x8 Qf[4], Q2f[4];
        { float f[4][8]; rope_frags(c.Z + rowi * EVEN_IN + ZRQ + h * 128 + quad * 8, c.COS + (size_t)(pos0 + i) * 64 + quad * 8, c.SIN + (size_t)(pos0 + i) * 64 + quad * 8, 1.0f, f);
          const float qd = __expf(logg * (float)(i + 1));
#pragma unroll
          for (int s = 0; s < 4; ++s) { Qf[s] = packf8(f[s], 1.0f); Q2f[s] = packf8(f[s], qd); } }
        f32x4 sc[4];
#pragma unroll
        for (int jt = 0; jt < 4; ++jt) {
            if (jt <= it) {
                const int j = jt * 16 + l15;
                float f[4][8]; rope_frags(c.Z + (size_t)(row0 + j) * EVEN_IN + ZRK + h * 128 + quad * 8, c.COS + (size_t)(pos0 + j) * 64 + quad * 8, c.SIN + (size_t)(pos0 + j) * 64 + quad * 8, 0.08838834764831845f, f);
                f32x4 acc = {0.f, 0.f, 0.f, 0.f};
#pragma unroll
                for (int s = 0; s < 4; ++s) acc = MFMA16(packf8(f[s], 1.0f), Qf[s], acc);
#pragma unroll
                for (int e = 0; e < 4; ++e) { const int diff = i - (jt * 16 + quad * 4 + e); sc[jt][e] = diff >= 0 ? acc[e] * __expf(logg * (float)diff) : 0.f; }
            } else sc[jt] = (f32x4){0.f, 0.f, 0.f, 0.f};
        }
        f32x4 O[8];
#pragma unroll
        for (int et = 0; et < 8; ++et) O[et] = (f32x4){0.f, 0.f, 0.f, 0.f};
#pragma unroll
        for (int jb = 0; jb < 2; ++jb) {
            if (jb * 32 < T && jb * 2 <= it) {
                u32x4 pw; pw.x = pk2(sc[2 * jb][0], sc[2 * jb][1]); pw.y = pk2(sc[2 * jb][2], sc[2 * jb][3]); pw.z = pk2(sc[2 * jb + 1][0], sc[2 * jb + 1][1]); pw.w = pk2(sc[2 * jb + 1][2], sc[2 * jb + 1][3]);
                const bf16x8 Pf = __builtin_bit_cast(bf16x8, pw);
#pragma unroll
                for (int et = 0; et < 8; ++et) {
                    const s16x4 lo = *(const LAS s16x4*)(VT + (et * 16 + l15) * 72 + jb * 32 + quad * 4), hi = *(const LAS s16x4*)(VT + (et * 16 + l15) * 72 + jb * 32 + 16 + quad * 4);
                    O[et] = MFMA16(__builtin_shufflevector(lo, hi, 0, 1, 2, 3, 4, 5, 6, 7), Pf, O[et]);
                }
            }
        }
#pragma unroll
        for (int s = 0; s < 4; ++s)
#pragma unroll
            for (int et = 0; et < 8; ++et) { const bf16x8 Sf = *(const LAS bf16x8*)(ST + (et * 16 + l15) * 136 + s * 32 + quad * 8); O[et] = MFMA16(Sf, Q2f[s], O[et]); }
        float sm = 0.f;
#pragma unroll
        for (int et = 0; et < 8; ++et) sm += (O[et][0] + O[et][1]) + (O[et][2] + O[et][3]);
        sm += __shfl_xor(sm, 16); sm += __shfl_xor(sm, 32);
        const float mu = sm * (1.0f / 128.0f); float q = 0.f;
#pragma unroll
        for (int et = 0; et < 8; ++et) { O[et] = O[et] - mu; q += dot4(O[et]); }
        q += __shfl_xor(q, 16); q += __shfl_xor(q, 32);
        const float rstd = 1.f / sqrtf(q * (1.0f / 128.0f) + EPS);
#pragma unroll
        for (int et = 0; et < 8; ++et) { const int e = h * 128 + et * 16 + quad * 4;
            const f32x4 g4 = *(const f32x4*)(c.a.in[I_RETG] + e); const u32x2 rgw = *(const u32x2*)(c.Z + rowi * EVEN_IN + ZRG + e);
            const float r0 = bflo(rgw.x), r1 = bfhi(rgw.x), r2 = bflo(rgw.y), r3 = bfhi(rgw.y);
            const f32x4 y = O[et] * rstd * g4;
            u32x2 wv; wv.x = pk2(y.x * (r0 / (1.f + __expf(-r0))), y.y * (r1 / (1.f + __expf(-r1)))); wv.y = pk2(y.z * (r2 / (1.f + __expf(-r2))), y.w * (r3 / (1.f + __expf(-r3))));
            *(u32x2*)(c.MIX + rowi * DM + 1024 + e) = wv; }
    }
    __syncthreads();
}
DI void swa_cache_out(Ctx& c) {
    const int gt = c.bx * 512 + c.tid, NT = gridDim.x * 512;
    float* out = c.a.out;
    for (int i = gt; i < 2 * 128 * 256; i += NT) {
        const int b = i >> 15, t = (i >> 8) & 127, cidx = i & 255; const size_t zr = (size_t)(b * 4096 + 3968 + t) * EVEN_IN;
        out[O_KP + i] = bflo((unsigned)c.Z[zr + ZK + cidx]); out[O_VP + i] = bflo((unsigned)c.Z[zr + ZV + cidx]);
    }
    for (int i = gt; i < 16 * 128 * 256; i += NT) {
        const int b = i >> 15, t = (i >> 8) & 127, cidx = i & 255;
        if (t < 96) { const size_t s = ((size_t)(b * 128 + t + 32)) * 256 + cidx; out[O_KS + i] = c.a.in[I_CK][s]; out[O_VS + i] = c.a.in[I_CV][s]; }
        else { const size_t zr = (size_t)(MPR + b * 32 + t - 96) * EVEN_IN; out[O_KS + i] = bflo((unsigned)c.Z[zr + ZK + cidx]); out[O_VS + i] = bflo((unsigned)c.Z[zr + ZV + cidx]); }
    }
}

DI void row_pass(Ctx& c, bool from_x, const float* g_res, const float* g_next) {
    const int gw = c.bx * 8 + c.wave, NGW = gridDim.x * 8, lane = c.lane;
    for (int m = gw; m < M; m += NGW) {
        const float* hs = from_x ? (m < MPR ? c.a.in[I_XP] + (size_t)m * DM : c.a.in[I_XS] + (size_t)(m - MPR) * DM) : c.H + (size_t)m * DM;
        const f32x4* mp = (const f32x4*)(c.MPB + (size_t)m * DM);
        f32x4 v[8]; float s = 0.f;
#pragma unroll
        for (int j = 0; j < 8; ++j) { v[j] = mp[lane + 64 * j]; s += dot4(v[j]); }
        const float r1 = 1.f / sqrtf(wave_sum(s) * (1.f / DM) + EPS);
        float s2 = 0.f;
#pragma unroll
        for (int j = 0; j < 8; ++j) { const f32x4 g = ((const f32x4*)g_res)[lane + 64 * j]; v[j] = ((const f32x4*)hs)[lane + 64 * j] + v[j] * r1 * g; s2 += dot4(v[j]);
            ((f32x4*)(c.H + (size_t)m * DM))[lane + 64 * j] = v[j]; }
        if (g_next) {
            const float r2 = 1.f / sqrtf(wave_sum(s2) * (1.f / DM) + EPS);
#pragma unroll
            for (int j = 0; j < 8; ++j) { const f32x4 g = ((const f32x4*)g_next)[lane + 64 * j]; const f32x4 o = v[j] * r2 * g;
                u32x2 wv; wv.x = pk2(o.x, o.y); wv.y = pk2(o.z, o.w); ((u32x2*)(c.XN + (size_t)m * DM))[lane + 64 * j] = wv; }
        }
    }
}
DI void conv_gate(Ctx& c, int layer) {
    const int gt = c.bx * 512 + c.tid, NT = gridDim.x * 512;
    const float* cw = c.a.in[I_CW] + (size_t)layer * 3 * DFF2; const float* cb = c.a.in[I_CB] + (size_t)layer * DFF2;
    const float* stt = c.a.in[I_SCONV] + (size_t)layer * 16 * 2 * DFF2;
    for (int item = gt; item < (M / 16) * (DFF / 8); item += NT) {
        const int rb = item / (DFF / 8), c0 = (item % (DFF / 8)) * 8, r0 = rb * 16;
        float pa[2][8], pg[2][8];
        bool zero = false, fromstate = false; int sb = 0;
        if (r0 < MPR) zero = (r0 & 4095) == 0; else { const int rs = r0 - MPR; fromstate = (rs & 31) == 0; sb = rs >> 5; }
#pragma unroll
        for (int p = 0; p < 2; ++p) {
            if (zero) {
#pragma unroll
                for (int k = 0; k < 8; ++k) { pa[p][k] = 0.f; pg[p][k] = 0.f; }
            } else if (fromstate) { const float* sp = stt + (size_t)(sb * 2 + p) * DFF2 + c0;
                *(f32x4*)&pa[p][0] = *(const f32x4*)sp; *(f32x4*)&pa[p][4] = *(const f32x4*)(sp + 4); *(f32x4*)&pg[p][0] = *(const f32x4*)(sp + DFF); *(f32x4*)&pg[p][4] = *(const f32x4*)(sp + DFF + 4);
            } else { const bf16* hp = c.HRAW + (size_t)(r0 - 2 + p) * DFF2 + c0; const u32x4 xa = *(const u32x4*)hp, xg = *(const u32x4*)(hp + DFF);
#pragma unroll
                for (int k = 0; k < 4; ++k) { pa[p][2 * k] = bflo(xa[k]); pa[p][2 * k + 1] = bfhi(xa[k]); pg[p][2 * k] = bflo(xg[k]); pg[p][2 * k + 1] = bfhi(xg[k]); } }
        }
        float wa[3][8], wg[3][8], ba[8], bg[8];
#pragma unroll
        for (int i = 0; i < 3; ++i) { *(f32x4*)&wa[i][0] = *(const f32x4*)(cw + i * DFF2 + c0); *(f32x4*)&wa[i][4] = *(const f32x4*)(cw + i * DFF2 + c0 + 4);
            *(f32x4*)&wg[i][0] = *(const f32x4*)(cw + i * DFF2 + DFF + c0); *(f32x4*)&wg[i][4] = *(const f32x4*)(cw + i * DFF2 + DFF + c0 + 4); }
        *(f32x4*)&ba[0] = *(const f32x4*)(cb + c0); *(f32x4*)&ba[4] = *(const f32x4*)(cb + c0 + 4); *(f32x4*)&bg[0] = *(const f32x4*)(cb + DFF + c0); *(f32x4*)&bg[4] = *(const f32x4*)(cb + DFF + c0 + 4);
#pragma unroll 4
        for (int r = 0; r < 16; ++r) {
            const bf16* hp = c.HRAW + (size_t)(r0 + r) * DFF2 + c0; const u32x4 xa = *(const u32x4*)hp, xg = *(const u32x4*)(hp + DFF);
            float ca[8], cg[8], o[8];
#pragma unroll
            for (int k = 0; k < 4; ++k) { ca[2 * k] = bflo(xa[k]); ca[2 * k + 1] = bfhi(xa[k]); cg[2 * k] = bflo(xg[k]); cg[2 * k + 1] = bfhi(xg[k]); }
#pragma unroll
            for (int k = 0; k < 8; ++k) { const float av = ba[k] + pa[0][k] * wa[0][k] + pa[1][k] * wa[1][k] + ca[k] * wa[2][k]; const float gv = bg[k] + pg[0][k] * wg[0][k] + pg[1][k] * wg[1][k] + cg[k] * wg[2][k];
                o[k] = pg8::gelu_tanh(gv) * av; pa[0][k] = pa[1][k]; pa[1][k] = ca[k]; pg[0][k] = pg[1][k]; pg[1][k] = cg[k]; }
            u32x4 wv; wv.x = pk2(o[0], o[1]); wv.y = pk2(o[2], o[3]); wv.z = pk2(o[4], o[5]); wv.w = pk2(o[6], o[7]);
            *(u32x4*)(c.ACT + (size_t)(r0 + r) * DFF + c0) = wv;
        }
    }
}
DI void sgate_unit(Ctx& c, int u) {
    const int tid = c.tid, w = c.wave, l15 = c.l15, quad = c.quad;
    const bool sample = u >= 512;
    int g, row0, L, sb = 0;
    if (!sample) { g = u & 7; row0 = (u >> 3) * 128; L = 128; } else { const int us = u - 512; sb = us >> 3; g = us & 7; row0 = MPR + sb * 32; L = 32; }
    LAS bf16* VNT = (LAS bf16*)c.lds;
    const float* lng = c.a.in[I_LNG] + g * 256; const float* lnb = c.a.in[I_LNB] + g * 256;
    for (int idx = tid; idx < L * 32; idx += 512) {
        const int j = idx >> 5, c0 = (idx & 31) * 8; const size_t row = (size_t)(row0 + j);
        const float mean = c.STATS[2 * row] * (1.f / 2048.f); const float var = c.STATS[2 * row + 1] * (1.f / 2048.f) - mean * mean; const float rstd = 1.f / sqrtf(fmaxf(var, 0.f) + EPS);
        const u32x4 vv = *(const u32x4*)(c.UV + row * 4096 + 2048 + g * 256 + c0);
        float vn[8];
#pragma unroll
        for (int k = 0; k < 8; ++k) { const float x = (k & 1) ? bfhi(vv[k >> 1]) : bflo(vv[k >> 1]); vn[k] = (x - mean) * rstd * lng[c0 + k] + lnb[c0 + k]; VNT[(c0 + k) * 136 + j] = (bf16)f2bf(vn[k]); }
        if (sample) { float* go = c.a.out + O_GV + (size_t)(sb * 32 + j) * 2048 + g * 256 + c0; *(f32x4*)go = *(f32x4*)&vn[0]; *(f32x4*)(go + 4) = *(f32x4*)&vn[4]; }
    }
    __syncthreads();
    int it, ct0, nct;
    if (!sample) { it = w; ct0 = 0; nct = 16; } else { it = w & 1; ct0 = (w >> 1) * 4; nct = 4; }
    const int i = it * 16 + l15;
    bf16x8 Wf[4];
    const float* wrow = c.a.in[I_GWS] + (size_t)(g * 128 + i) * 128 + quad * 8;
#pragma unroll
    for (int s = 0; s < 4; ++s) {
        if (s * 32 <= it * 16 + 15) { float f[8]; *(f32x4*)&f[0] = *(const f32x4*)(wrow + s * 32); *(f32x4*)&f[4] = *(const f32x4*)(wrow + s * 32 + 4);
#pragma unroll
            for (int k = 0; k < 8; ++k) if (s * 32 + quad * 8 + k > i) f[k] = 0.f;
            Wf[s] = packf8(f, 1.0f); }
        else Wf[s] = (bf16x8){0, 0, 0, 0, 0, 0, 0, 0};
    }
    const float bias = c.a.in[I_GBS][g * 128 + i];
    const size_t row = (size_t)(row0 + i);
    for (int cti = 0; cti < nct; ++cti) {
        const int ct = ct0 + cti; f32x4 acc = {0.f, 0.f, 0.f, 0.f};
#pragma unroll
        for (int s = 0; s < 4; ++s) if (s * 32 <= it * 16 + 15) { const bf16x8 av = *(const LAS bf16x8*)(VNT + (ct * 16 + l15) * 136 + s * 32 + quad * 8); acc = MFMA16(av, Wf[s], acc); }
        const int col = g * 256 + ct * 16 + quad * 4;
        const u32x2 uw = *(const u32x2*)(c.UV + row * 4096 + col);
        u32x2 wv; wv.x = pk2(bflo(uw.x) * (acc[0] + bias), bfhi(uw.x) * (acc[1] + bias)); wv.y = pk2(bflo(uw.y) * (acc[2] + bias), bfhi(uw.y) * (acc[3] + bias));
        *(u32x2*)(c.MIX + row * DM + col) = wv;
    }
    __syncthreads();
}

__global__ void __launch_bounds__(512, 2) mega(Args args) {
    extern __shared__ __attribute__((aligned(16))) unsigned char lds_raw[];
    cg::grid_group grid = cg::this_grid();
    for (int ph = args.ph_lo; ph < args.ph_hi; ++ph) {
    Ctx c;
    { int t_ = threadIdx.x; asm volatile("" : "+v"(t_)); c.tid = t_; }
    c.lds = (LAS unsigned char*)lds_raw; c.lane = c.tid & 63; c.wave = __builtin_amdgcn_readfirstlane(c.tid >> 6); c.l15 = c.lane & 15; c.quad = c.lane >> 4; c.a = args;
    unsigned char* ws = args.ws; asm volatile("" : "+s"(ws));
    int bx = blockIdx.x; asm volatile("" : "+s"(bx));
    const int G = gridDim.x; c.bx = bx;
    c.Z = (bf16*)(ws + WS_Z); c.XN = (bf16*)(ws + WS_XN); c.MIX = (bf16*)(ws + WS_MIX); c.ACT = (bf16*)(ws + WS_ACT); c.HRAW = (bf16*)(ws + WS_HRAW); c.UV = (bf16*)(ws + WS_UV); c.STB = (bf16*)(ws + WS_ST);
    c.MPB = (float*)(ws + WS_MPB); c.KV = (float*)(ws + WS_KV); c.COS = (float*)(ws + WS_COS); c.SIN = (float*)(ws + WS_SIN); c.STATS = (float*)(ws + WS_STATS); c.H = args.out + O_Y;
        if (ph == PH_PRO) prologue(c);
        else if (ph == PH_WIN_E) {
            pg8::Gemm g{c.XN, (const bf16*)(ws + WS_WINE), M, EVEN_IN, DM}; pg8::StaticOrder S; S.init(M, EVEN_IN, G, bx);
            pg8::EpiBf16 E{c.Z, EVEN_IN};
            pg8::gemm_phase<pg8::EpiBf16, pg8::StaticOrder, true, true>(c.lds, g, S, E);
        } else if (ph == PH_MIXA) {
            for (int u = bx; u < 576 + 1152; u += G) { if (u < 576) swa_unit(c, u); else retkv_unit(c, u - 576); }
            swa_cache_out(c);
        } else if (ph == PH_SCAN) ret_scan(c);
        else if (ph == PH_MIXC) { for (int u = bx; u < 576; u += G) retout_pair(c, u); }
        else if (ph == PH_WOUT_E || ph == PH_WOUT_O || ph == PH_DOWN0 || ph == PH_DOWN1) {
            const bool dn = (ph == PH_DOWN0 || ph == PH_DOWN1); const int K = dn ? DFF : DM;
            const bf16* A = dn ? c.ACT : c.MIX;
            const bf16* B = ph == PH_WOUT_E ? (const bf16*)(ws + WS_WOUTE) : ph == PH_WOUT_O ? (const bf16*)(ws + WS_WOUTO) : (const bf16*)(ws + WS_WDN) + (ph == PH_DOWN1 ? (size_t)DFF * DM : 0);
            pg8::Gemm g{A, B, M, DM, K}; pg8::StaticOrder S; S.init(M, DM, G, bx);
            pg8::EpiF32 E{c.MPB, DM};
            pg8::gemm_phase<pg8::EpiF32, pg8::StaticOrder, true, true>(c.lds, g, S, E);
        } else if (ph == PH_UP0 || ph == PH_UP1) {
            const int L = ph == PH_UP1;
            pg8::Gemm g{c.XN, (const bf16*)(ws + WS_WUP) + (size_t)L * DFF2 * DM, M, DFF2, DM}; pg8::StaticOrder S; S.init(M, DFF2, G, bx);
            pg8::EpiUp E{c.HRAW, DFF2, args.out + O_CP + (size_t)L * 2 * 2 * DFF2, args.out + O_CS + (size_t)L * 16 * 2 * DFF2};
            pg8::gemm_phase<pg8::EpiUp, pg8::StaticOrder, true, true>(c.lds, g, S, E);
        } else if (ph == PH_CONV0 || ph == PH_CONV1) conv_gate(c, ph == PH_CONV1);
        else if (ph == PH_ROWA0) row_pass(c, true, args.in[I_NORMG] + 1 * DM, args.in[I_NORMG] + 2 * DM);
        else if (ph == PH_ROWB0) row_pass(c, false, args.in[I_NORMG] + 3 * DM, args.in[I_NORMG] + 4 * DM);
        else if (ph == PH_ROWA1) row_pass(c, false, args.in[I_NORMG] + 5 * DM, args.in[I_NORMG] + 6 * DM);
        else if (ph == PH_ROWB1) row_pass(c, false, args.in[I_NORMG] + 7 * DM, nullptr);
        else if (ph == PH_WIN_O) {
            pg8::Gemm g{c.XN, (const bf16*)(ws + WS_WINO), M, 4096, DM}; pg8::StaticOrder S; S.init(M, 4096, G, bx);
            pg8::EpiGeluStats E{c.UV, 4096, c.STATS, 2048};
            pg8::gemm_phase<pg8::EpiGeluStats, pg8::StaticOrder, true, true>(c.lds, g, S, E);
        } else if (ph == PH_SGATE) { for (int u = bx; u < 640; u += G) sgate_unit(c, u); }
        if (ph + 1 < args.ph_hi) grid.sync();
    }
}

extern "C" void kernel_launch(void* const* d_in, const int* in_sizes, int n_in, void* d_out, int out_size, void* d_ws, size_t ws_size, hipStream_t stream) {
    static int grid = 0;
    if (grid == 0) {
        if (n_in != 21 || (size_t)out_size != O_END || ws_size < WS_END) { fprintf(stderr, "kernel_launch: unexpected shapes: n_in %d out %d ws %zu\n", n_in, out_size, ws_size); grid = -1; return; }
        int dev = 0, cus = 0, per_cu = 0;
        hipGetDevice(&dev); hipDeviceGetAttribute(&cus, hipDeviceAttributeMultiprocessorCount, dev);
        hipFuncSetAttribute((const void*)mega, hipFuncAttributeMaxDynamicSharedMemorySize, LDS_BYTES);
        if (hipOccupancyMaxActiveBlocksPerMultiprocessor(&per_cu, (const void*)mega, 512, LDS_BYTES) != hipSuccess || per_cu < 1) { fprintf(stderr, "kernel_launch: occupancy query says %d\n", per_cu); per_cu = 1; }
        (void)hipGetLastError();
        grid = cus * 1;
    }
    if (grid < 0) return;
    hipMemsetAsync((char*)d_ws + WS_CTL, 0, CTL_BYTES, stream);
    Args a{};
    for (int i = 0; i < 21; ++i) a.in[i] = (const float*)d_in[i];
    a.out = (float*)d_out; a.ws = (unsigned char*)d_ws;
#if ONE_LAUNCH
    a.ph_lo = 0; a.ph_hi = NPH; void* kargs[] = {&a};
    hipError_t e = hipLaunchCooperativeKernel((const void*)mega, dim3(grid), dim3(512), kargs, LDS_BYTES, stream);
    if (e != hipSuccess) fprintf(stderr, "cooperative launch failed: %s (grid %d)\n", hipGetErrorString(e), grid);
#else
    for (int ph = 0; ph < NPH; ++ph) { a.ph_lo = ph; a.ph_hi = ph + 1; hipLaunchKernelGGL(mega, dim3(grid), dim3(512), LDS_BYTES, stream, a); }
#endif
}
```

```cpp
#include <hip/hip_runtime.h>
#include <hip/hip_cooperative_groups.h>
#include <cstdio>
#include <cstdint>
namespace cg = cooperative_groups;
#ifndef ONE_LAUNCH
#define ONE_LAUNCH 1
#endif
namespace pg8 {
#define PG8_LAS __attribute__((address_space(3)))
typedef unsigned short bf16_t;
typedef short bf16x8 __attribute__((ext_vector_type(8)));
typedef float f32x4 __attribute__((ext_vector_type(4)));
typedef unsigned u32x4 __attribute__((ext_vector_type(4)));
constexpr int BM = 256, BK = 64, HALF = 128, HTB = HALF * BK * 2  , STAGE_BYTES = 8 * HTB, NXCD = 8, WGM = 8;

__host__ __device__ __forceinline__ int lds_byte(int r, int c) { const int st = (r >> 4) * 2 + (c >> 5), rr = r & 15, cc = c & 31, ob = rr * 64 + cc * 2; return st * 1024 + (ob ^ (((ob >> 9) & 1) << 5)); }
__host__ __device__ __forceinline__ void stage_rc(int b, int& R, int& C) { const int st = b / 1024, sb = b % 1024, swz = sb ^ (((sb >> 9) & 1) << 5); R = (st >> 1) * 16 + swz / 64; C = (st & 1) * 32 + (swz % 64) / 2; }
__host__ __device__ __forceinline__ int perm32(int rho) { const int n = rho >> 4, i = rho & 15; return 8 * (i >> 2) + 4 * n + (i & 3); }

struct Unit { int pm, pn, k0, nt, split; };
struct Gemm { const bf16_t* A; const bf16_t* Bt; int M, N, K; };

struct StaticOrder {
    int nM, nN, nwg, G, c, ntk;
    __host__ __device__ void init(int M, int N, int G_, int c_, int K) { nM = M / BM; nN = N / BM; nwg = nM * nN; G = G_; c = c_; ntk = K / BK; }
    __host__ __device__ __forceinline__ bool next(int i, Unit& u) const {
        const long L = (long)i * G + c; if (L >= nwg) return false;
        int wgid = (int)L; { const int q = nwg / NXCD, r = nwg % NXCD, xcd = wgid % NXCD, off = wgid / NXCD; wgid = (xcd < r ? xcd * (q + 1) : r * (q + 1) + (xcd - r) * q) + off; }
        const int nig = WGM * nN, gid = wgid / nig, fm = gid * WGM, gsz = (nM - fm) < WGM ? (nM - fm) : WGM;
        u.pm = fm + ((wgid % nig) % gsz); u.pn = (wgid % nig) / gsz; u.k0 = 0; u.nt = ntk; u.split = 0; return true;
    }
    __device__ __forceinline__ void a_ready(const Unit&) const {}
    __device__ __forceinline__ void done(const Unit&) const {}
};
struct SplitOrder {
    StaticOrder so; int np, G, c, S, ntk, nN, pm0, nsplit;
    __host__ __device__ void init(int Mp, int Ms, int N, int K, int G_, int c_, int S_) { so.init(Mp, N, G_, c_, K); G = G_; c = c_; S = S_; ntk = K / BK; nN = N / BM; pm0 = Mp / BM; nsplit = (Ms / BM) * nN * S;
        np = so.nwg > c ? (so.nwg - c + G - 1) / G : 0; }
    __host__ __device__ __forceinline__ bool next(int i, Unit& u) const {
        if ((c & 1) && np == 1 && nsplit <= G && c < nsplit && i < 2) i = 1 - i;
        Unit p; p.pm = 0; p.pn = 0; p.k0 = 0; p.nt = ntk; p.split = 0;
        const bool okp = (i < np) ? so.next(i, p) : false;
        const int Ls = (i - np) * G + c; const bool oks = (i >= np) && (Ls < nsplit);
        const int tile = Ls / S, ks = Ls % S, nts = ntk / S;
        u.pm = oks ? pm0 + tile / nN : p.pm; u.pn = oks ? tile % nN : p.pn; u.nt = oks ? nts : p.nt; u.k0 = oks ? ks * nts : p.k0; u.split = oks ? 1 : 0;
        return okp || oks;
    }
    __device__ __forceinline__ void a_ready(const Unit&) const {}
    __device__ __forceinline__ void done(const Unit&) const {}
};


__device__ __forceinline__ unsigned cvt_pk_bf16(float lo, float hi) { unsigned r; asm volatile("v_cvt_pk_bf16_f32 %0, %1, %2" : "=v"(r) : "v"(lo), "v"(hi)); return r; }
typedef float f32x2 __attribute__((ext_vector_type(2)));
__device__ __forceinline__ float gelu_tanh(float x) { const float t = x * (-2.3022082f + -0.10294324f * (x * x)); return x * __builtin_amdgcn_rcpf(1.f + __builtin_amdgcn_exp2f(t)); }
struct EpiBf16 {
    static constexpr bool PERM = true, AFTER_DRAIN = false;
    bf16_t* O; int ldc;
    __device__ __forceinline__ void operator()(const f32x4 (&acc)[2][2][4][2], const Unit& u, int wr, int wc, int fr, int fq) const {
        const int row0 = u.pm * BM + wr * 64 + fr, col0 = u.pn * BM + wc * 32 + 8 * fq;
#pragma unroll
        for (int ai = 0; ai < 2; ++ai)
#pragma unroll
            for (int m = 0; m < 4; ++m) { bf16_t* rowp = O + (size_t)(row0 + ai * HALF + m * 16) * ldc + col0;
#pragma unroll
                for (int bj = 0; bj < 2; ++bj) { const f32x4 v0 = acc[ai][bj][m][0], v1 = acc[ai][bj][m][1];
                    u32x4 w; w.x = cvt_pk_bf16(v0[0], v0[1]); w.y = cvt_pk_bf16(v0[2], v0[3]); w.z = cvt_pk_bf16(v1[0], v1[1]); w.w = cvt_pk_bf16(v1[2], v1[3]);
                    *(u32x4*)(rowp + bj * HALF) = w; } }
    }
};
struct EpiUp {
    static constexpr bool PERM = true, AFTER_DRAIN = false;
    bf16_t* O; int ldc; float* cp; float* cs;
    __device__ __forceinline__ void operator()(const f32x4 (&acc)[2][2][4][2], const Unit& u, int wr, int wc, int fr, int fq) const {
        const int row0 = u.pm * BM + wr * 64 + fr, col0 = u.pn * BM + wc * 32 + 8 * fq;
        const bool may = (u.pm >= 32) || ((u.pm & 15) == 15);
#pragma unroll
        for (int ai = 0; ai < 2; ++ai)
#pragma unroll
            for (int m = 0; m < 4; ++m) { const int row = row0 + ai * HALF + m * 16; bf16_t* rowp = O + (size_t)row * ldc + col0;
                float* so = nullptr;
                if (may) {
                    if (row < 8192) { const int t = row & 4095; if (t >= 4094) so = cp + (size_t)((row >> 12) * 2 + (t - 4094)) * ldc + col0; }
                    else { const int rs = row - 8192, t = rs & 31; if (t >= 30) so = cs + (size_t)((rs >> 5) * 2 + (t - 30)) * ldc + col0; } }
#pragma unroll
                for (int bj = 0; bj < 2; ++bj) { const f32x4 v0 = acc[ai][bj][m][0], v1 = acc[ai][bj][m][1];
                    u32x4 w; w.x = cvt_pk_bf16(v0[0], v0[1]); w.y = cvt_pk_bf16(v0[2], v0[3]); w.z = cvt_pk_bf16(v1[0], v1[1]); w.w = cvt_pk_bf16(v1[2], v1[3]);
                    *(u32x4*)(rowp + bj * HALF) = w;
                    if (so) { *(f32x4*)(so + bj * HALF) = v0; *(f32x4*)(so + bj * HALF + 4) = v1; } } }
    }
};
struct EpiF32 {
    static constexpr bool PERM = true, AFTER_DRAIN = false;
    bf16_t* O; int ldc; float* PB; int pm0;
    __device__ __forceinline__ void operator()(const f32x4 (&acc)[2][2][4][2], const Unit& u, int wr, int wc, int fr, int fq) const {
        const int row0 = u.pm * BM + wr * 64 + fr, col0 = u.pn * BM + wc * 32 + 8 * fq;
        if (!u.split) {
#pragma unroll
            for (int ai = 0; ai < 2; ++ai)
#pragma unroll
                for (int m = 0; m < 4; ++m) { bf16_t* rowp = O + (size_t)(row0 + ai * HALF + m * 16) * ldc + col0;
#pragma unroll
                    for (int bj = 0; bj < 2; ++bj) { const f32x4 v0 = acc[ai][bj][m][0], v1 = acc[ai][bj][m][1];
                        u32x4 w; w.x = cvt_pk_bf16(v0[0], v0[1]); w.y = cvt_pk_bf16(v0[2], v0[3]); w.z = cvt_pk_bf16(v1[0], v1[1]); w.w = cvt_pk_bf16(v1[2], v1[3]);
                        *(u32x4*)(rowp + bj * HALF) = w; } }
        } else {
            bf16_t* base = (bf16_t*)PB + ((size_t)(u.k0 / u.nt) * 512 - (size_t)pm0 * BM) * ldc;
#pragma unroll
            for (int ai = 0; ai < 2; ++ai)
#pragma unroll
                for (int m = 0; m < 4; ++m) { bf16_t* rowp = base + (size_t)(row0 + ai * HALF + m * 16) * ldc + col0;
#pragma unroll
                    for (int bj = 0; bj < 2; ++bj) { const f32x4 v0 = acc[ai][bj][m][0], v1 = acc[ai][bj][m][1];
                        u32x4 w; w.x = cvt_pk_bf16(v0[0], v0[1]); w.y = cvt_pk_bf16(v0[2], v0[3]); w.z = cvt_pk_bf16(v1[0], v1[1]); w.w = cvt_pk_bf16(v1[2], v1[3]);
                        *(u32x4*)(rowp + bj * HALF) = w; } }
        }
    }
};
struct EpiGeluStats {
    static constexpr bool PERM = true, AFTER_DRAIN = false;
    bf16_t* O; int ldc; float* stats; int vcol0;
    __device__ __forceinline__ void operator()(const f32x4 (&acc)[2][2][4][2], const Unit& u, int wr, int wc, int fr, int fq) const {
        const int row0 = u.pm * BM + wr * 64 + fr, col0 = u.pn * BM + wc * 32 + 8 * fq;
        const bool isv = u.pn * BM >= vcol0;
#pragma unroll
        for (int ai = 0; ai < 2; ++ai)
#pragma unroll
            for (int m = 0; m < 4; ++m) { const int row = row0 + ai * HALF + m * 16; bf16_t* rowp = O + (size_t)row * ldc + col0;
                float s = 0.f, q = 0.f;
#pragma unroll
                for (int bj = 0; bj < 2; ++bj) { f32x4 v0 = acc[ai][bj][m][0], v1 = acc[ai][bj][m][1];
#pragma unroll
                    for (int e = 0; e < 4; ++e) { v0[e] = gelu_tanh(v0[e]); v1[e] = gelu_tanh(v1[e]); s += v0[e] + v1[e]; q += v0[e] * v0[e] + v1[e] * v1[e]; }
                    u32x4 w; w.x = cvt_pk_bf16(v0[0], v0[1]); w.y = cvt_pk_bf16(v0[2], v0[3]); w.z = cvt_pk_bf16(v1[0], v1[1]); w.w = cvt_pk_bf16(v1[2], v1[3]);
                    *(u32x4*)(rowp + bj * HALF) = w; }
                if (isv) { s += __shfl_xor(s, 16); s += __shfl_xor(s, 32); q += __shfl_xor(q, 16); q += __shfl_xor(q, 32);
                    if (fq == 0) { unsafeAtomicAdd(stats + 2 * row, s); unsafeAtomicAdd(stats + 2 * row + 1, q); } } }
    }
};
template <class Epi, class Sched, bool ALIGN_EPI = false, bool SP2 = false>
__device__ __forceinline__ void gemm_phase(PG8_LAS unsigned char* lds, const Gemm g, const Sched& S, const Epi& E) {
    int tid_ = threadIdx.x; asm volatile("" : "+v"(tid_)); const int tid = tid_, wid = __builtin_amdgcn_readfirstlane(tid >> 6), lane = tid & 63, wr = wid >> 2, wc = wid & 3, fr = lane & 15, fq = lane >> 4;
    const int K = g.K, nt = K / BK;
    unsigned voffA[2], voffB[2];
#pragma unroll
    for (int i = 0; i < 2; ++i) { int R, C; stage_rc(tid * 16 + i * 8192, R, C); const int Rb = Epi::PERM ? ((R & ~31) + perm32(R & 31)) : R;
        voffA[i] = (unsigned)(R * K + C) * 2u; voffB[i] = (unsigned)(Rb * K + C) * 2u; }
    const size_t kstep = (size_t)(BK * 2);
    const size_t hstep = (size_t)HALF * K * 2;
    const size_t tstep = 2 * hstep;
    const unsigned ldsw = (unsigned)wid * 1024u;
    const int aoff = lds_byte(wr * 64 + fr, fq * 8), boff = lds_byte(wc * 32 + fr, fq * 8);
#define PG8_SA(b, h) (((b) * 2 + (h)) * HTB)
#define PG8_SB(b, h) ((4 + (b) * 2 + (h)) * HTB)
#define PG8_STAGE(bufoff, gbase, voff) do { _Pragma("unroll") for (int _i = 0; _i < 2; ++_i) \
        __builtin_amdgcn_global_load_lds((const unsigned*)((const char*)(gbase) + (voff)[_i]), (PG8_LAS unsigned*)(lds + (bufoff) + ldsw + _i * 8192), 16, 0, 0); } while (0)
#define PG8_LDA(dst, b, h) do { _Pragma("unroll") for (int m = 0; m < 4; ++m) _Pragma("unroll") for (int k = 0; k < 2; ++k) dst[m][k] = *(const PG8_LAS bf16x8*)(lds + PG8_SA(b, h) + aoff + m * 2048 + k * 1024); } while (0)
#define PG8_LDB(dst, b, h) do { _Pragma("unroll") for (int n = 0; n < 2; ++n) _Pragma("unroll") for (int k = 0; k < 2; ++k) dst[n][k] = *(const PG8_LAS bf16x8*)(lds + PG8_SB(b, h) + boff + n * 2048 + k * 1024); } while (0)
#define PG8_MMA(ai, bj, At, Bt) do { __builtin_amdgcn_s_setprio(1); _Pragma("unroll") for (int m = 0; m < 4; ++m) _Pragma("unroll") for (int n = 0; n < 2; ++n) _Pragma("unroll") for (int k = 0; k < 2; ++k) \
        acc[ai][bj][m][n] = __builtin_amdgcn_mfma_f32_16x16x32_bf16(Bt[n][k], At[m][k], acc[ai][bj][m][n], 0, 0, 0); __builtin_amdgcn_s_setprio(0); } while (0)
#define PG8_WAIT_V(n) asm volatile("s_waitcnt vmcnt(" #n ")" ::: "memory")
#define PG8_WAIT_L(n) asm volatile("s_waitcnt lgkmcnt(" #n ")" ::: "memory")
#define PG8_BAR __builtin_amdgcn_s_barrier()
#define PG8_SCHED __builtin_amdgcn_sched_barrier(0)
    Unit cur, nxt; int ui = 0;
    if (!S.next(0, cur)) return;
    f32x4 acc[2][2][4][2];
#pragma unroll
    for (int a = 0; a < 2; ++a)
#pragma unroll
        for (int b = 0; b < 2; ++b)
#pragma unroll
            for (int m = 0; m < 4; ++m)
#pragma unroll
                for (int n = 0; n < 2; ++n) acc[a][b][m][n] = (f32x4){0.f, 0.f, 0.f, 0.f};
    bf16x8 At[4][2], B0[2][2], B1[2][2];
    const char* cA = (const char*)g.A + (size_t)cur.pm * tstep + (size_t)cur.k0 * kstep; const char* cB = (const char*)g.Bt + (size_t)cur.pn * tstep + (size_t)cur.k0 * kstep;
    S.a_ready(cur);
    if constexpr (SP2) {
        PG8_STAGE(PG8_SB(0, 0), cB, voffB); PG8_STAGE(PG8_SB(0, 1), cB + hstep, voffB); PG8_STAGE(PG8_SA(0, 0), cA, voffA); PG8_STAGE(PG8_SA(0, 1), cA + hstep, voffA);
        if (wr == 1) PG8_BAR;
        PG8_WAIT_V(2); PG8_BAR;
        PG8_STAGE(PG8_SB(1, 0), cB + kstep, voffB); PG8_STAGE(PG8_SA(1, 0), cA + kstep, voffA); PG8_STAGE(PG8_SB(1, 1), cB + hstep + kstep, voffB);
        PG8_WAIT_V(6); PG8_BAR;
    } else {
        PG8_STAGE(PG8_SB(0, 0), cB, voffB); PG8_STAGE(PG8_SA(0, 0), cA, voffA); PG8_STAGE(PG8_SB(0, 1), cB + hstep, voffB); PG8_STAGE(PG8_SA(0, 1), cA + hstep, voffA);
        if (wr == 1) PG8_BAR;
        PG8_WAIT_V(4); PG8_BAR;
        PG8_STAGE(PG8_SB(1, 0), cB + kstep, voffB); PG8_STAGE(PG8_SA(1, 0), cA + kstep, voffA); PG8_STAGE(PG8_SB(1, 1), cB + hstep + kstep, voffB);
        PG8_WAIT_V(6); PG8_BAR;
    }
    for (;;) {
        const bool has_next = S.next(ui + 1, nxt);
        const char* nA = has_next ? (const char*)g.A + (size_t)nxt.pm * tstep + (size_t)nxt.k0 * kstep : cA; const char* nB = has_next ? (const char*)g.Bt + (size_t)nxt.pn * tstep + (size_t)nxt.k0 * kstep : cB;
        const int cnt = cur.nt;
        for (int t = 0; t < cnt; t += 2) {
            const bool last = (t == cnt - 2);
            const char* a1 = cA + (size_t)(t + 1) * kstep;
            const char* a2 = last ? nA : cA + (size_t)(t + 2) * kstep; const char* b2 = last ? nB : cB + (size_t)(t + 2) * kstep;
            const char* a3 = a2 + kstep; const char* b3 = b2 + kstep;
            if (last && has_next) S.a_ready(nxt);
            if constexpr (SP2) {
            PG8_LDB(B0, 0, 0); PG8_LDB(B1, 0, 1); PG8_SCHED; PG8_LDA(At, 0, 0); PG8_STAGE(PG8_SA(1, 1), a1 + hstep, voffA);
            PG8_WAIT_V(8); PG8_WAIT_L(0); PG8_BAR; PG8_MMA(0, 0, At, B0); PG8_MMA(0, 1, At, B1); PG8_BAR; PG8_SCHED;
            PG8_LDA(At, 0, 1); PG8_STAGE(PG8_SB(0, 0), b2, voffB); PG8_STAGE(PG8_SB(0, 1), b2 + hstep, voffB); PG8_STAGE(PG8_SA(0, 0), a2, voffA);
            PG8_WAIT_V(8); PG8_WAIT_L(0); PG8_BAR; PG8_MMA(1, 0, At, B0); PG8_MMA(1, 1, At, B1); PG8_BAR; PG8_SCHED;
            PG8_LDB(B0, 1, 0); PG8_LDB(B1, 1, 1); PG8_SCHED; PG8_LDA(At, 1, 0); PG8_STAGE(PG8_SA(0, 1), a2 + hstep, voffA);
            PG8_WAIT_V(8); PG8_WAIT_L(0); PG8_BAR; PG8_MMA(0, 0, At, B0); PG8_MMA(0, 1, At, B1); PG8_BAR; PG8_SCHED;
            PG8_LDA(At, 1, 1); PG8_STAGE(PG8_SB(1, 0), b3, voffB); PG8_STAGE(PG8_SB(1, 1), b3 + hstep, voffB); PG8_STAGE(PG8_SA(1, 0), a3, voffA);
            PG8_WAIT_V(8); PG8_WAIT_L(0); PG8_BAR; PG8_MMA(1, 0, At, B0); PG8_MMA(1, 1, At, B1); PG8_BAR; PG8_SCHED;
            } else {
            PG8_LDB(B0, 0, 0); PG8_SCHED; PG8_LDA(At, 0, 0); PG8_STAGE(PG8_SA(1, 1), a1 + hstep, voffA);
            PG8_WAIT_L(8); PG8_BAR; PG8_WAIT_L(0); PG8_MMA(0, 0, At, B0); PG8_BAR; PG8_SCHED;
            PG8_LDB(B1, 0, 1); PG8_STAGE(PG8_SB(0, 0), b2, voffB);
            PG8_BAR; PG8_WAIT_L(0); PG8_MMA(0, 1, At, B1); PG8_BAR;
            PG8_LDA(At, 0, 1); PG8_STAGE(PG8_SA(0, 0), a2, voffA);
            PG8_BAR; PG8_WAIT_L(0); PG8_MMA(1, 0, At, B0); PG8_BAR; PG8_SCHED;
            PG8_STAGE(PG8_SB(0, 1), b2 + hstep, voffB);
            PG8_WAIT_V(6); PG8_BAR; PG8_MMA(1, 1, At, B1); PG8_BAR;
            PG8_LDB(B0, 1, 0); PG8_SCHED; PG8_LDA(At, 1, 0); PG8_STAGE(PG8_SA(0, 1), a2 + hstep, voffA);
            PG8_WAIT_L(8); PG8_BAR; PG8_WAIT_L(0); PG8_MMA(0, 0, At, B0); PG8_BAR; PG8_SCHED;
            PG8_LDB(B1, 1, 1); PG8_STAGE(PG8_SB(1, 0), b3, voffB);
            PG8_BAR; PG8_WAIT_L(0); PG8_MMA(0, 1, At, B1); PG8_BAR;
            PG8_LDA(At, 1, 1); PG8_STAGE(PG8_SA(1, 0), a3, voffA);
            PG8_BAR; PG8_WAIT_L(0); PG8_MMA(1, 0, At, B0); PG8_BAR; PG8_SCHED;
            PG8_STAGE(PG8_SB(1, 1), b3 + hstep, voffB);
            PG8_WAIT_V(6); PG8_BAR; PG8_MMA(1, 1, At, B1); PG8_BAR;
            }
        }
        if constexpr (ALIGN_EPI) { if (wr == 0) PG8_BAR; }
        if constexpr (!Epi::AFTER_DRAIN) { E(acc, cur, wr, wc, fr, fq); S.done(cur); }
        if (!has_next) break;
#pragma unroll
        for (int a = 0; a < 2; ++a)
#pragma unroll
            for (int b = 0; b < 2; ++b)
#pragma unroll
                for (int m = 0; m < 4; ++m)
#pragma unroll
                    for (int n = 0; n < 2; ++n) acc[a][b][m][n] = (f32x4){0.f, 0.f, 0.f, 0.f};
        cur = nxt; cA = nA; cB = nB; ++ui;
        if constexpr (ALIGN_EPI) { if (wr == 1) PG8_BAR; }
    }
    PG8_WAIT_V(0);
    if constexpr (!ALIGN_EPI) { if (wr == 0) PG8_BAR; }
    PG8_BAR;
    if constexpr (Epi::AFTER_DRAIN) { E.fused(acc, cur, wr, wc, fr, fq, lds, wid, lane); S.done(cur); }
#undef PG8_SA
#undef PG8_SB
#undef PG8_STAGE
#undef PG8_LDA
#undef PG8_LDB
#undef PG8_MMA
#undef PG8_WAIT_V
#undef PG8_WAIT_L
#undef PG8_BAR
#undef PG8_SCHED
}
}
#define DI __device__ __forceinline__
#define LAS __attribute__((address_space(3)))
typedef unsigned short bf16;
typedef float f32x4 __attribute__((ext_vector_type(4)));
typedef short bf16x8 __attribute__((ext_vector_type(8)));
typedef short s16x4 __attribute__((ext_vector_type(4)));
typedef unsigned u32x4 __attribute__((ext_vector_type(4)));
typedef unsigned u32x2 __attribute__((ext_vector_type(2)));
typedef float f32x2 __attribute__((ext_vector_type(2)));
#define MFMA16(a, b, c) __builtin_amdgcn_mfma_f32_16x16x32_bf16((a), (b), (c), 0, 0, 0)

constexpr int DM = 2048, MPR = 8192, M = 8704, EVEN_IN = 5632, DFF = 5632, DFF2 = 11264;
constexpr int ZQ = 0, ZK = 1024, ZV = 1280, ZRQ = 1536, ZRK = 2560, ZRV = 3584, ZRG = 4608;
constexpr float EPS = 1e-6f;
constexpr size_t O_Y = 0, O_KP = 17825792, O_VP = 17891328, O_RP = 17956864, O_CP = 18219008, O_KS = 18309120, O_VS = 18833408,
                 O_RS = 19357696, O_CS = 21454848, O_GV = 22175744, O_END = 23224320;
constexpr size_t MiB = 1u << 20;
constexpr size_t WS_CTL = 0, CTL_BYTES = 1 * MiB, WS_STATS = 65536;
constexpr size_t WS_COS = 1 * MiB, WS_SIN = 2 * MiB;
constexpr size_t WS_WINE = 3 * MiB, WS_WOUTE = 25 * MiB, WS_WINO = 33 * MiB, WS_WOUTO = 49 * MiB, WS_WUP = 57 * MiB, WS_WDN = 145 * MiB;
constexpr size_t WS_XN = 189 * MiB, WS_MIX = 223 * MiB, WS_MPB = 257 * MiB, WS_ACT = 325 * MiB, WS_A = 419 * MiB, WS_PB = 609 * MiB, WS_KP = 653 * MiB, WS_END = 671 * MiB;
constexpr size_t WS_Z = WS_A, WS_KV = WS_A + 94 * MiB, WS_ST = WS_A + 158 * MiB, WS_HRAW = WS_A, WS_UV = WS_A;
constexpr int LDS_BYTES = 131072 + 1024;

enum { PH_PRO = 0, PH_WIN_E, PH_MIXA, PH_SCAN, PH_MIXC, PH_WOUT_E, PH_ROWA0, PH_UP0, PH_CONV0, PH_DOWN0, PH_ROWB0,
       PH_WIN_O, PH_SGATE, PH_WOUT_O, PH_ROWA1, PH_UP1, PH_CONV1, PH_DOWN1, PH_ROWB1, NPH };

struct Args { const float* in[21]; float* out; unsigned char* ws; int ph_lo, ph_hi; };
enum { I_XP = 0, I_XS, I_CK, I_CV, I_SRET, I_SCONV, I_NORMG, I_WINE, I_WOUTE, I_SINK, I_RETG, I_WINO, I_WOUTO, I_LNG, I_LNB, I_GWS, I_GBS, I_WUP, I_CW, I_CB, I_WDN };

DI unsigned f2bf(float f) { unsigned u = __builtin_bit_cast(unsigned, f); return (u + 0x7fffu + ((u >> 16) & 1u)) >> 16; }
DI unsigned pk2(float lo, float hi) { unsigned r; asm volatile("v_cvt_pk_bf16_f32 %0, %1, %2" : "=v"(r) : "v"(lo), "v"(hi)); return r; }
DI float bflo(unsigned u) { return __builtin_bit_cast(float, u << 16); }
DI float bfhi(unsigned u) { return __builtin_bit_cast(float, u & 0xffff0000u); }
DI float wave_sum(float v) {
#pragma unroll
    for (int o = 1; o < 64; o <<= 1) v += __shfl_xor(v, o);
    return v;
}
typedef short v4i16_t __attribute__((ext_vector_type(4)));
DI s16x4 trd(const LAS bf16* p) { return __builtin_bit_cast(s16x4, __builtin_amdgcn_ds_read_tr16_b64_v4i16((LAS v4i16_t*)p)); }
DI bf16x8 trfrag(const LAS bf16* img, int pitch, int krowA, int krowB, int col0, int l15) {
    const int q = l15 >> 2, p = l15 & 3;
    const s16x4 lo = trd(img + (krowA + q) * pitch + col0 + 4 * p), hi = trd(img + (krowB + q) * pitch + col0 + 4 * p);
    return __builtin_shufflevector(lo, hi, 0, 1, 2, 3, 4, 5, 6, 7);
}
DI float dot4(f32x4 a) { return (a.x * a.x + a.y * a.y) + (a.z * a.z + a.w * a.w); }

struct Ctx {
    LAS unsigned char* lds; int tid, lane, wave, l15, quad, bx; Args a;
    bf16 *Z, *XN, *MIX, *ACT, *HRAW, *UV, *STB, *KP; float *KV, *COS, *SIN, *STATS, *H; bf16* MPB;
};

struct TItem { const float* src; bf16* dst; int N, K; };
DI void t_load(const TItem& t, float (&tv)[32], int lane) {
#pragma unroll
    for (int i = 0; i < 8; ++i) *(f32x4*)&tv[4 * i] = __builtin_nontemporal_load((const f32x4*)(t.src + (size_t)(8 * i + (lane >> 3)) * t.N + (lane & 7) * 4));
}
DI void t_store(const TItem& t, const float (&tv)[32], LAS float* scr, int lane) {
#pragma unroll
    for (int i = 0; i < 8; ++i)
#pragma unroll
        for (int e2 = 0; e2 < 4; ++e2) scr[(8 * i + (lane >> 3)) * 33 + (lane & 7) * 4 + e2] = tv[4 * i + e2];
    asm volatile("s_waitcnt lgkmcnt(0)" ::: "memory");
    const int cc = lane & 7;
#pragma unroll
    for (int j = 0; j < 4; ++j) { const int n = (lane >> 3) + 8 * j; const LAS float* s = scr + (8 * cc) * 33 + n;
        u32x4 o; o.x = pk2(s[0 * 33], s[1 * 33]); o.y = pk2(s[2 * 33], s[3 * 33]); o.z = pk2(s[4 * 33], s[5 * 33]); o.w = pk2(s[6 * 33], s[7 * 33]);
        *(u32x4*)(t.dst + (size_t)n * t.K + 8 * cc) = o; }
    asm volatile("s_waitcnt lgkmcnt(0)" ::: "memory");
}
DI void rms_row_to_bf16(const float* xrow, const float* g, bf16* orow, int lane) {
    f32x4 v[8]; float s = 0.f;
#pragma unroll
    for (int j = 0; j < 8; ++j) { v[j] = __builtin_nontemporal_load((const f32x4*)xrow + lane + 64 * j); s += dot4(v[j]); }
    const float r = 1.f / sqrtf(wave_sum(s) * (1.f / DM) + EPS);
#pragma unroll
    for (int j = 0; j < 8; ++j) { const f32x4 gg = ((const f32x4*)g)[lane + 64 * j]; const f32x4 o = v[j] * r * gg;
        u32x2 w; w.x = pk2(o.x, o.y); w.y = pk2(o.z, o.w); ((u32x2*)orow)[lane + 64 * j] = w; }
}
DI void prologue(Ctx& c) {
    LAS float* scr = (LAS float*)(c.lds + c.wave * 16384);
    const int gw = c.bx * 8 + c.wave, NGW = gridDim.x * 8;
    unsigned char* ws = c.a.ws;
    constexpr int I0 = 32 * 176, I1 = 32 * 64, I2 = 32 * 128, I3 = 32 * 64, I4 = 32 * 352, I5 = 88 * 64;
    constexpr int NIT = I0 + I1 + I2 + I3 + 2 * I4 + 2 * I5;
#define T_DECODE(t, it_) do { int r_ = (it_); const float* W_; bf16* D_; int K_, N_; \
        if (r_ < I0) { W_ = c.a.in[I_WINE]; D_ = (bf16*)(ws + WS_WINE); K_ = 2048; N_ = 5632; } \
        else if ((r_ -= I0) < I1) { W_ = c.a.in[I_WOUTE]; D_ = (bf16*)(ws + WS_WOUTE); K_ = 2048; N_ = 2048; } \
        else if ((r_ -= I1) < I2) { W_ = c.a.in[I_WINO]; D_ = (bf16*)(ws + WS_WINO); K_ = 2048; N_ = 4096; } \
        else if ((r_ -= I2) < I3) { W_ = c.a.in[I_WOUTO]; D_ = (bf16*)(ws + WS_WOUTO); K_ = 2048; N_ = 2048; } \
        else if ((r_ -= I3) < 2 * I4) { const int L_ = r_ / I4; r_ -= L_ * I4; W_ = c.a.in[I_WUP] + (size_t)L_ * 2048 * 11264; D_ = (bf16*)(ws + WS_WUP) + (size_t)L_ * 2048 * 11264; K_ = 2048; N_ = 11264; } \
        else { r_ -= 2 * I4; const int L_ = r_ / I5; r_ -= L_ * I5; W_ = c.a.in[I_WDN] + (size_t)L_ * 5632 * 2048; D_ = (bf16*)(ws + WS_WDN) + (size_t)L_ * 5632 * 2048; K_ = 5632; N_ = 2048; } \
        const int nblk_ = N_ / 32, q_ = r_ >> 3, w8_ = r_ & 7, kb_ = 2 * (q_ / (nblk_ / 4)) + (w8_ >> 2), nb_ = 4 * (q_ % (nblk_ / 4)) + (w8_ & 3);     \
        (t).src = W_ + (size_t)(64 * kb_) * N_ + 32 * nb_; (t).dst = D_ + (size_t)(32 * nb_) * K_ + 64 * kb_; (t).N = N_; (t).K = K_; } while (0)
    {
        TItem ta, tb; float va[32], vb[32];
        int it = gw;
        if (it < NIT) { T_DECODE(ta, it); t_load(ta, va, c.lane); }
        for (; it < NIT; it += 2 * NGW) {
            const int i2 = it + NGW; const bool h2 = i2 < NIT;
            if (h2) { T_DECODE(tb, i2); t_load(tb, vb, c.lane); }
            t_store(ta, va, scr, c.lane);
            const int i3 = i2 + NGW;
            if (i3 < NIT) { T_DECODE(ta, i3); t_load(ta, va, c.lane); }
            if (h2) t_store(tb, vb, scr, c.lane);
        }
    }
#undef T_DECODE
    const float* g0 = c.a.in[I_NORMG];
    for (int m = gw; m < M; m += NGW) {
        const float* xr = m < MPR ? c.a.in[I_XP] + (size_t)m * DM : c.a.in[I_XS] + (size_t)(m - MPR) * DM;
        rms_row_to_bf16(xr, g0, c.XN + (size_t)m * DM, c.lane);
    }
    const int gt = c.bx * 512 + c.tid, NT = gridDim.x * 512;
    for (int i = gt; i < 4096 * 64; i += NT) { const int pos = i >> 6, d = i & 63;
        const float freq = 1.0f / powf(10000.0f, (float)d * (1.0f / 64.0f)); const float ang = (float)pos * freq;
        float sn, cs; sincosf(ang, &sn, &cs); c.COS[i] = cs; c.SIN[i] = sn; }
}

DI u32x4 pack8(const float* p) { const f32x4 a = *(const f32x4*)p, b = *(const f32x4*)(p + 4); u32x4 r; r.x = pk2(a.x, a.y); r.y = pk2(a.z, a.w); r.z = pk2(b.x, b.y); r.w = pk2(b.z, b.w); return r; }
DI void swa_unit(Ctx& c, int u) {
    const int tid = c.tid, w = c.wave, l15 = c.l15, quad = c.quad;
    const bool sample = u >= 512;
    int b, hk, qrow0, krow0 = 0, nkt, ktb;
    if (!sample) { b = u >> 8; const int ch = (u >> 2) & 63; hk = u & 3; qrow0 = b * 4096 + ch * 64; krow0 = qrow0 - 128; nkt = 12; ktb = ch < 2 ? (2 - ch) * 4 : 0; }
    else { const int us = u - 512; b = us >> 2; hk = us & 3; qrow0 = MPR + b * 32; nkt = 10; ktb = 0; }
    LAS bf16* Ks = (LAS bf16*)c.lds;
    LAS bf16* Vs = (LAS bf16*)(c.lds + 192 * 144);
    for (int idx = tid; idx < nkt * 128; idx += 512) {
        const int kk = idx >> 3, seg = idx & 7;
        u32x4 kv = {0u, 0u, 0u, 0u}, vv = {0u, 0u, 0u, 0u};
        if (!sample) { if (kk >= ktb * 16) { const bf16* zr = c.Z + (size_t)(krow0 + kk) * EVEN_IN + hk * 64 + seg * 8; kv = *(const u32x4*)(zr + ZK); vv = *(const u32x4*)(zr + ZV); } }
        else if (kk < 128) { const size_t off = ((size_t)(b * 128 + kk) * 4 + hk) * 64 + seg * 8; kv = pack8(c.a.in[I_CK] + off); vv = pack8(c.a.in[I_CV] + off); }
        else { const bf16* zr = c.Z + (size_t)(qrow0 + kk - 128) * EVEN_IN + hk * 64 + seg * 8; kv = *(const u32x4*)(zr + ZK); vv = *(const u32x4*)(zr + ZV); }
        *(LAS u32x4*)(Ks + kk * 72 + seg * 8) = kv; *(LAS u32x4*)(Vs + kk * 72 + seg * 8) = vv;
    }
    const int head = hk * 4 + (w >> 1);
    const float sink = c.a.in[I_SINK][head];
    const int nqt = sample ? 1 : 2;
    bf16x8 Qall[2][2];
#pragma unroll
    for (int qt = 0; qt < 2; ++qt) { const int qloc = sample ? (w & 1) * 16 : (w & 1) * 32 + qt * 16; const size_t qrow = (size_t)(qrow0 + qloc + l15);
#pragma unroll
        for (int s = 0; s < 2; ++s) Qall[qt][s] = __builtin_nontemporal_load((const bf16x8*)(c.Z + qrow * EVEN_IN + ZQ + head * 64 + s * 32 + quad * 8)); }
    __syncthreads();
#pragma unroll
    for (int qt = 0; qt < 2; ++qt) {
        if (qt < nqt) {
        const int qloc = sample ? (w & 1) * 16 : (w & 1) * 32 + qt * 16;
        const size_t qrow = (size_t)(qrow0 + qloc + l15);
        bf16x8 Qf[2]; Qf[0] = Qall[qt][0]; Qf[1] = Qall[qt][1];
        f32x4 st[12];
        float mx = sink;
#pragma unroll
        for (int kt = 0; kt < 12; ++kt) {
            if (kt >= ktb && kt < nkt) {
                const bf16x8 a0 = *(const LAS bf16x8*)(Ks + (kt * 16 + l15) * 72 + quad * 8), a1 = *(const LAS bf16x8*)(Ks + (kt * 16 + l15) * 72 + 32 + quad * 8);
                f32x4 acc = {0.f, 0.f, 0.f, 0.f}; acc = MFMA16(a0, Qf[0], acc); acc = MFMA16(a1, Qf[1], acc);
                st[kt] = acc * 0.125f;
                mx = fmaxf(mx, fmaxf(fmaxf(st[kt][0], st[kt][1]), fmaxf(st[kt][2], st[kt][3])));
            } else st[kt] = (f32x4){-INFINITY, -INFINITY, -INFINITY, -INFINITY};
        }
        mx = fmaxf(mx, __shfl_xor(mx, 16)); mx = fmaxf(mx, __shfl_xor(mx, 32));
        float sum = 0.f;
#pragma unroll
        for (int kt = 0; kt < 12; ++kt)
#pragma unroll
            for (int e = 0; e < 4; ++e) { const float p = __expf(st[kt][e] - mx); st[kt][e] = p; sum += p; }
        sum += __shfl_xor(sum, 16); sum += __shfl_xor(sum, 32); sum += __expf(sink - mx);
        f32x4 O[4];
#pragma unroll
        for (int dt = 0; dt < 4; ++dt) O[dt] = (f32x4){0.f, 0.f, 0.f, 0.f};
#pragma unroll
        for (int kb = 0; kb < 6; ++kb) {
            if (kb * 2 < nkt && kb * 2 + 1 >= ktb) {
                u32x4 pw; pw.x = pk2(st[2 * kb][0], st[2 * kb][1]); pw.y = pk2(st[2 * kb][2], st[2 * kb][3]); pw.z = pk2(st[2 * kb + 1][0], st[2 * kb + 1][1]); pw.w = pk2(st[2 * kb + 1][2], st[2 * kb + 1][3]);
                const bf16x8 Pf = __builtin_bit_cast(bf16x8, pw);
#pragma unroll
                for (int dt = 0; dt < 4; ++dt) {
                    const bf16x8 Vf = trfrag(Vs, 72, kb * 32 + quad * 4, kb * 32 + 16 + quad * 4, dt * 16, l15);
                    O[dt] = MFMA16(Vf, Pf, O[dt]);
                }
            }
        }
        const float inv = 1.f / sum;
#pragma unroll
        for (int dt = 0; dt < 4; ++dt) { const f32x4 o = O[dt] * inv; u32x2 wv; wv.x = pk2(o.x, o.y); wv.y = pk2(o.z, o.w);
            *(u32x2*)(c.MIX + qrow * DM + head * 64 + dt * 16 + quad * 4) = wv; }
        }
    }
    __syncthreads();
}

DI float ret_logg(int h) { return log1pf(-exp2f(-5.0f - (float)h)); }
DI void rope_frags(const bf16* zr  , const float* cosr  , const float* sinr, float scale, float (&f)[4][8]) {
    u32x4 x[4];
#pragma unroll
    for (int s = 0; s < 4; ++s) x[s] = *(const u32x4*)(zr + s * 32);
#pragma unroll
    for (int s2 = 0; s2 < 2; ++s2) {
        float cs[8], sn[8];
        *(f32x4*)&cs[0] = *(const f32x4*)(cosr + s2 * 32); *(f32x4*)&cs[4] = *(const f32x4*)(cosr + s2 * 32 + 4);
        *(f32x4*)&sn[0] = *(const f32x4*)(sinr + s2 * 32); *(f32x4*)&sn[4] = *(const f32x4*)(sinr + s2 * 32 + 4);
#pragma unroll
        for (int k = 0; k < 8; ++k) { const unsigned w1 = x[s2][k >> 1], w2 = x[s2 + 2][k >> 1];
            const float a = (k & 1) ? bfhi(w1) : bflo(w1), bb = (k & 1) ? bfhi(w2) : bflo(w2);
            f[s2][k] = (a * cs[k] - bb * sn[k]) * scale; f[s2 + 2][k] = (bb * cs[k] + a * sn[k]) * scale; }
    }
}
DI bf16x8 packf8(const float (&f)[8], float sc) { u32x4 r; r.x = pk2(f[0] * sc, f[1] * sc); r.y = pk2(f[2] * sc, f[3] * sc); r.z = pk2(f[4] * sc, f[5] * sc); r.w = pk2(f[6] * sc, f[7] * sc); return __builtin_bit_cast(bf16x8, r); }

DI void retkv_unit(Ctx& c, int u) {
    const int tid = c.tid, w = c.wave, l15 = c.l15, quad = c.quad;
    const bool sample = u >= 1024;
    int b, n = 0, h, row0, pos0, T;
    if (!sample) { b = u >> 9; n = (u >> 3) & 63; h = u & 7; row0 = b * 4096 + n * 64; pos0 = n * 64; T = 64; }
    else { const int us = u - 1024; b = us >> 3; h = us & 7; row0 = MPR + b * 32; pos0 = 1024; T = 32; }
    const float logg = ret_logg(h);
    LAS bf16* Kn = (LAS bf16*)c.lds;
    LAS bf16* Vn = (LAS bf16*)(c.lds + 64 * 288);
    for (int idx = tid; idx < T * 8; idx += 512) {
        const int j = idx >> 3, d0 = (idx & 7) * 8;
        const bf16* zr = c.Z + (size_t)(row0 + j) * EVEN_IN + ZRK + h * 128 + d0;
        const u32x4 x1 = *(const u32x4*)zr, x2 = *(const u32x4*)(zr + 64);
        const float* cr = c.COS + (size_t)(pos0 + j) * 64 + d0; const float* sr = c.SIN + (size_t)(pos0 + j) * 64 + d0;
        float cs[8], sn[8];
        *(f32x4*)&cs[0] = *(const f32x4*)cr; *(f32x4*)&cs[4] = *(const f32x4*)(cr + 4); *(f32x4*)&sn[0] = *(const f32x4*)sr; *(f32x4*)&sn[4] = *(const f32x4*)(sr + 4);
        const float dec = __expf(logg * (float)(T - 1 - j));
        float o1[8], o2[8];
#pragma unroll
        for (int k = 0; k < 8; ++k) { const unsigned w1 = x1[k >> 1], w2 = x2[k >> 1];
            const float a = (k & 1) ? bfhi(w1) : bflo(w1), bb = (k & 1) ? bfhi(w2) : bflo(w2);
            o1[k] = (a * cs[k] - bb * sn[k]) * 0.08838834764831845f; o2[k] = (bb * cs[k] + a * sn[k]) * 0.08838834764831845f;
        }
        { u32x4 q1, q2; q1.x = pk2(o1[0] * dec, o1[1] * dec); q1.y = pk2(o1[2] * dec, o1[3] * dec); q1.z = pk2(o1[4] * dec, o1[5] * dec); q1.w = pk2(o1[6] * dec, o1[7] * dec);
          q2.x = pk2(o2[0] * dec, o2[1] * dec); q2.y = pk2(o2[2] * dec, o2[3] * dec); q2.z = pk2(o2[4] * dec, o2[5] * dec); q2.w = pk2(o2[6] * dec, o2[7] * dec);
          *(LAS u32x4*)(Kn + j * 144 + d0) = q1; *(LAS u32x4*)(Kn + j * 144 + 64 + d0) = q2; }
        { bf16* kp = c.KP + (size_t)(row0 + j) * 1024 + h * 128 + d0;
          u32x4 p1, p2; p1.x = pk2(o1[0], o1[1]); p1.y = pk2(o1[2], o1[3]); p1.z = pk2(o1[4], o1[5]); p1.w = pk2(o1[6], o1[7]); p2.x = pk2(o2[0], o2[1]); p2.y = pk2(o2[2], o2[3]); p2.z = pk2(o2[4], o2[5]); p2.w = pk2(o2[6], o2[7]);
          *(u32x4*)kp = p1; *(u32x4*)(kp + 64) = p2; }
    }
    for (int idx = tid; idx < T * 16; idx += 512) {
        const int j = idx >> 4, e0 = (idx & 15) * 8;
        const u32x4 vv = *(const u32x4*)(c.Z + (size_t)(row0 + j) * EVEN_IN + ZRV + h * 128 + e0);
        *(LAS u32x4*)(Vn + j * 144 + e0) = vv;
    }
    __syncthreads();
    f32x4 acc[8];
#pragma unroll
    for (int dt = 0; dt < 8; ++dt) acc[dt] = (f32x4){0.f, 0.f, 0.f, 0.f};
#pragma unroll
    for (int s = 0; s < 2; ++s) {
        if (s * 32 < T) {
            const bf16x8 av = trfrag(Vn, 144, s * 32 + quad * 8, s * 32 + quad * 8 + 4, w * 16, l15);
#pragma unroll
            for (int dt = 0; dt < 8; ++dt) { const bf16x8 bk = trfrag(Kn, 144, s * 32 + quad * 8, s * 32 + quad * 8 + 4, dt * 16, l15); acc[dt] = MFMA16(av, bk, acc[dt]); }
        }
    }
    if (!sample) {
        float* o = c.KV + (size_t)((b * 64 + n) * 8 + h) * 16384;
#pragma unroll
        for (int dt = 0; dt < 8; ++dt) *(f32x4*)(o + (dt * 16 + l15) * 128 + w * 16 + quad * 4) = acc[dt];
    } else {
        const float cd = __expf(logg * 32.0f);
        const float* st = c.a.in[I_SRET] + (size_t)(b * 8 + h) * 16384; float* o = c.a.out + O_RS + (size_t)(b * 8 + h) * 16384;
#pragma unroll
        for (int dt = 0; dt < 8; ++dt) { const int off = (dt * 16 + l15) * 128 + w * 16 + quad * 4; *(f32x4*)(o + off) = *(const f32x4*)(st + off) * cd + acc[dt]; }
    }
    __syncthreads();
}
DI void ret_scan(Ctx& c) {
    const int gt = c.bx * 512 + c.tid, NT = gridDim.x * 512;
    for (int i = gt; i < 16 * 8192; i += NT) {
        const int bh = i >> 13, off = (i & 8191) * 2, b = bh >> 3, h = bh & 7;
        const float cd = __expf(ret_logg(h) * 64.0f);
        float s0 = 0.f, s1 = 0.f;
        const float* kv = c.KV + (size_t)(b * 64 * 8 + h) * 16384 + off; bf16* st = c.STB + (size_t)(b * 64 * 8 + h) * 16384 + off;
#pragma unroll 16
        for (int n = 0; n < 64; ++n) { *(unsigned*)(st + (size_t)n * 8 * 16384) = pk2(s0, s1);
            const f32x2 v = __builtin_nontemporal_load((const f32x2*)(kv + (size_t)n * 8 * 16384)); s0 = cd * s0 + v.x; s1 = cd * s1 + v.y; }
        float* o = c.a.out + O_RP + (size_t)bh * 16384 + off; o[0] = s0; o[1] = s1;
    }
}
DI void retout_pair(Ctx& c, int pu) {
    const int tid = c.tid, w = c.wave, l15 = c.l15, quad = c.quad, sub = w >> 2, it = w & 3, t256 = tid & 255;
    const bool sample = pu >= 512;
    int b, n = 0, h, row0, pos0, T;
    if (!sample) { const int u = pu * 2 + sub; b = u >> 9; n = (u >> 3) & 63; h = u & 7; row0 = b * 4096 + n * 64; pos0 = n * 64; T = 64; }
    else { const int us = (pu - 512) * 2 + sub; b = us >> 3; h = us & 7; row0 = MPR + b * 32; pos0 = 1024; T = 32; }
    LAS bf16* Vn = (LAS bf16*)(c.lds + sub * 55296);
    LAS bf16* ST = Vn + 64 * 144;
    for (int idx = t256; idx < T * 16; idx += 256) {
        const int j = idx >> 4, e0 = (idx & 15) * 8;
        const u32x4 vv = *(const u32x4*)(c.Z + (size_t)(row0 + j) * EVEN_IN + ZRV + h * 128 + e0);
        *(LAS u32x4*)(Vn + j * 144 + e0) = vv;
    }
    if (!sample) { const bf16* src = c.STB + (size_t)((b * 64 + n) * 8 + h) * 16384;
        for (int idx = t256; idx < 2048; idx += 256) { const int d = idx >> 4, e0 = (idx & 15) * 8; *(LAS u32x4*)(ST + d * 144 + e0) = __builtin_nontemporal_load((const u32x4*)(src + d * 128 + e0)); } }
    else { const float* src = c.a.in[I_SRET] + (size_t)(b * 8 + h) * 16384;
        for (int idx = t256; idx < 4096; idx += 256) { const int d = idx >> 5, e0 = (idx & 31) * 4; const f32x4 v = *(const f32x4*)(src + d * 128 + e0);
            u32x2 pv; pv.x = pk2(v[0], v[1]); pv.y = pk2(v[2], v[3]); *(LAS u32x2*)(ST + d * 144 + e0) = pv; } }
    const float logg = ret_logg(h);
    const int i = (it * 16 < T) ? it * 16 + l15 : l15; const size_t rowi = (size_t)(row0 + i);
    bf16x8 Kf[4][4];
#pragma unroll
    for (int jt = 0; jt < 4; ++jt) { const int jtc = jt * 16 < T ? jt : 0; const bf16* kp = c.KP + (size_t)(row0 + jtc * 16 + l15) * 1024 + h * 128 + quad * 8;
#pragma unroll
        for (int s = 0; s < 4; ++s) Kf[jt][s] = *(const bf16x8*)(kp + s * 32); }
    bf16x8 Qf[4], Q2f[4];
    { float f4[4][8]; rope_frags(c.Z + rowi * EVEN_IN + ZRQ + h * 128 + quad * 8, c.COS + (size_t)(pos0 + i) * 64 + quad * 8, c.SIN + (size_t)(pos0 + i) * 64 + quad * 8, 1.0f, f4);
      const float qd = __expf(logg * (float)(i + 1));
#pragma unroll
      for (int s = 0; s < 4; ++s) { Qf[s] = packf8(f4[s], 1.0f); Q2f[s] = packf8(f4[s], qd); } }
    __syncthreads();
    if (it * 16 < T) {
        f32x4 sc[4];
#pragma unroll
        for (int jt = 0; jt < 4; ++jt) {
            if (jt <= it) {
                f32x4 acc = {0.f, 0.f, 0.f, 0.f};
#pragma unroll
                for (int s = 0; s < 4; ++s) acc = MFMA16(Kf[jt][s], Qf[s], acc);
#pragma unroll
                for (int e = 0; e < 4; ++e) { const int diff = i - (jt * 16 + quad * 4 + e); sc[jt][e] = diff >= 0 ? acc[e] * __expf(logg * (float)diff) : 0.f; }
            } else sc[jt] = (f32x4){0.f, 0.f, 0.f, 0.f};
        }
        f32x4 O[8];
#pragma unroll
        for (int et = 0; et < 8; ++et) O[et] = (f32x4){0.f, 0.f, 0.f, 0.f};
#pragma unroll
        for (int jb = 0; jb < 2; ++jb) {
            if (jb * 32 < T && jb * 2 <= it) {
                u32x4 pw; pw.x = pk2(sc[2 * jb][0], sc[2 * jb][1]); pw.y = pk2(sc[2 * jb][2], sc[2 * jb][3]); pw.z = pk2(sc[2 * jb + 1][0], sc[2 * jb + 1][1]); pw.w = pk2(sc[2 * jb + 1][2], sc[2 * jb + 1][3]);
                const bf16x8 Pf = __builtin_bit_cast(bf16x8, pw);
#pragma unroll
                for (int et = 0; et < 8; ++et) {
                    O[et] = MFMA16(trfrag(Vn, 144, jb * 32 + quad * 4, jb * 32 + 16 + quad * 4, et * 16, l15), Pf, O[et]);
                }
            }
        }
#pragma unroll
        for (int s = 0; s < 4; ++s)
#pragma unroll
            for (int et = 0; et < 8; ++et) { const bf16x8 Sf = trfrag(ST, 144, s * 32 + quad * 8, s * 32 + quad * 8 + 4, et * 16, l15); O[et] = MFMA16(Sf, Q2f[s], O[et]); }
        float sm = 0.f;
#pragma unroll
        for (int et = 0; et < 8; ++et) sm += (O[et][0] + O[et][1]) + (O[et][2] + O[et][3]);
        sm += __shfl_xor(sm, 16); sm += __shfl_xor(sm, 32);
        const float mu = sm * (1.0f / 128.0f); float q = 0.f;
#pragma unroll
        for (int et = 0; et < 8; ++et) { O[et] = O[et] - mu; q += dot4(O[et]); }
        q += __shfl_xor(q, 16); q += __shfl_xor(q, 32);
        const float rstd = 1.f / sqrtf(q * (1.0f / 128.0f) + EPS);
#pragma unroll
        for (int et = 0; et < 8; ++et) { const int e = h * 128 + et * 16 + quad * 4;
            const f32x4 g4 = *(const f32x4*)(c.a.in[I_RETG] + e); const u32x2 rgw = *(const u32x2*)(c.Z + rowi * EVEN_IN + ZRG + e);
            const float r0 = bflo(rgw.x), r1 = bfhi(rgw.x), r2 = bflo(rgw.y), r3 = bfhi(rgw.y);
            const f32x4 y = O[et] * rstd * g4;
            u32x2 wv; wv.x = pk2(y.x * (r0 / (1.f + __expf(-r0))), y.y * (r1 / (1.f + __expf(-r1)))); wv.y = pk2(y.z * (r2 / (1.f + __expf(-r2))), y.w * (r3 / (1.f + __expf(-r3))));
            *(u32x2*)(c.MIX + rowi * DM + 1024 + e) = wv; }
    }
    __syncthreads();
}
DI void swa_cache_out(Ctx& c) {
    const int gt = c.bx * 512 + c.tid, NT = gridDim.x * 512;
    float* out = c.a.out;
    for (int i = gt; i < 2 * 128 * 256; i += NT) {
        const int b = i >> 15, t = (i >> 8) & 127, cidx = i & 255; const size_t zr = (size_t)(b * 4096 + 3968 + t) * EVEN_IN;
        out[O_KP + i] = bflo((unsigned)c.Z[zr + ZK + cidx]); out[O_VP + i] = bflo((unsigned)c.Z[zr + ZV + cidx]);
    }
    for (int i = gt; i < 16 * 128 * 256; i += NT) {
        const int b = i >> 15, t = (i >> 8) & 127, cidx = i & 255;
        if (t < 96) { const size_t s = ((size_t)(b * 128 + t + 32)) * 256 + cidx; out[O_KS + i] = c.a.in[I_CK][s]; out[O_VS + i] = c.a.in[I_CV][s]; }
        else { const size_t zr = (size_t)(MPR + b * 32 + t - 96) * EVEN_IN; out[O_KS + i] = bflo((unsigned)c.Z[zr + ZK + cidx]); out[O_VS + i] = bflo((unsigned)c.Z[zr + ZV + cidx]); }
    }
}

DI void row_finish(Ctx& c, int m, f32x4 (&v)[8], const f32x4 (&hv)[8], const f32x4 (&gr)[8], const float* g_next) {
    const int lane = c.lane; float s = 0.f;
#pragma unroll
    for (int j = 0; j < 8; ++j) s += dot4(v[j]);
    const float r1 = 1.f / sqrtf(wave_sum(s) * (1.f / DM) + EPS);
    float s2 = 0.f;
#pragma unroll
    for (int j = 0; j < 8; ++j) { v[j] = hv[j] + v[j] * r1 * gr[j]; s2 += dot4(v[j]); __builtin_nontemporal_store(v[j], (f32x4*)(c.H + (size_t)m * DM) + lane + 64 * j); }
    if (g_next) {
        const float r2 = 1.f / sqrtf(wave_sum(s2) * (1.f / DM) + EPS);
#pragma unroll
        for (int j = 0; j < 8; ++j) { const f32x4 o = v[j] * r2 * ((const f32x4*)g_next)[lane + 64 * j]; u32x2 wv; wv.x = pk2(o.x, o.y); wv.y = pk2(o.z, o.w); ((u32x2*)(c.XN + (size_t)m * DM))[lane + 64 * j] = wv; }
    }
}
DI void row_pass(Ctx& c, bool from_x, const float* g_res, const float* g_next, const float* PB, int S) {
    const int gw = c.bx * 8 + c.wave, NGW = gridDim.x * 8, lane = c.lane;
    f32x4 gr[8];
#pragma unroll
    for (int j = 0; j < 8; ++j) gr[j] = ((const f32x4*)g_res)[lane + 64 * j];
    const int NSW = (M - MPR) < NGW / 2 ? (M - MPR) : 0;
    if (gw < NSW) {
        const int m = MPR + gw;
        const float* hs = from_x ? c.a.in[I_XS] + (size_t)(m - MPR) * DM : c.H + (size_t)m * DM;
        f32x4 v[8], hv[8];
#pragma unroll
        for (int j = 0; j < 8; ++j) { hv[j] = ((const f32x4*)hs)[lane + 64 * j]; v[j] = (f32x4){0.f, 0.f, 0.f, 0.f}; }
        for (int sl = 0; sl < S; sl += 2) {
            const u32x2* p0 = (const u32x2*)((const bf16*)PB + ((size_t)sl * 512 + (m - MPR)) * DM); const bool two = sl + 1 < S;
            const u32x2* p1 = (const u32x2*)((const bf16*)PB + ((size_t)(two ? sl + 1 : sl) * 512 + (m - MPR)) * DM);
            u32x2 a[8], b[8];
#pragma unroll
            for (int j = 0; j < 8; ++j) { a[j] = __builtin_nontemporal_load(p0 + lane + 64 * j); b[j] = __builtin_nontemporal_load(p1 + lane + 64 * j); }
#pragma unroll
            for (int j = 0; j < 8; ++j) { v[j] += (f32x4){bflo(a[j].x), bfhi(a[j].x), bflo(a[j].y), bfhi(a[j].y)}; if (two) v[j] += (f32x4){bflo(b[j].x), bfhi(b[j].x), bflo(b[j].y), bfhi(b[j].y)}; }
        }
        row_finish(c, m, v, hv, gr, g_next);
        const int NPW = NGW - NSW, rem0 = (MPR / NPW) * NPW, mx = rem0 + gw;
        if (MPR - rem0 <= NSW && mx < MPR) {
            const float* h0 = from_x ? c.a.in[I_XP] + (size_t)mx * DM : c.H + (size_t)mx * DM;
            f32x4 v2[8], h2[8];
#pragma unroll
            for (int j = 0; j < 8; ++j) { const u32x2 a0 = ((const u32x2*)(c.MPB + (size_t)mx * DM))[lane + 64 * j]; v2[j] = (f32x4){bflo(a0.x), bfhi(a0.x), bflo(a0.y), bfhi(a0.y)}; h2[j] = ((const f32x4*)h0)[lane + 64 * j]; }
            row_finish(c, mx, v2, h2, gr, g_next);
        }
    } else {
        const int pw = gw - NSW, NPW = NGW - NSW; const int rem0_ = (MPR / NPW) * NPW; const int mend = NSW ? ((MPR - rem0_ <= NSW) ? rem0_ : MPR) : M;
#define ROW_LOAD(m_, mpv, hv_) do { const int mm_ = (m_); \
            const float* hh_ = from_x ? (mm_ < MPR ? c.a.in[I_XP] + (size_t)mm_ * DM : c.a.in[I_XS] + (size_t)(mm_ - MPR) * DM) : c.H + (size_t)mm_ * DM; \
            _Pragma("unroll") for (int j = 0; j < 8; ++j) { mpv[j] = __builtin_nontemporal_load((const u32x2*)(c.MPB + (size_t)mm_ * DM) + lane + 64 * j); hv_[j] = __builtin_nontemporal_load((const f32x4*)hh_ + lane + 64 * j); } } while (0)
#define ROW_DONE(m_, mpv, hv_) do { f32x4 v_[8]; _Pragma("unroll") for (int j = 0; j < 8; ++j) v_[j] = (f32x4){bflo(mpv[j].x), bfhi(mpv[j].x), bflo(mpv[j].y), bfhi(mpv[j].y)}; row_finish(c, (m_), v_, hv_, gr, g_next); } while (0)
        u32x2 pa[8], pb[8]; f32x4 ha[8], hb[8];
        int m0 = pw;
        if (m0 < mend) ROW_LOAD(m0, pa, ha);
        for (; m0 < mend; m0 += 2 * NPW) {
            const int m1 = m0 + NPW; const bool two = m1 < mend;
            if (two) ROW_LOAD(m1, pb, hb);
            ROW_DONE(m0, pa, ha);
            const int m2 = m1 + NPW;
            if (m2 < mend) ROW_LOAD(m2, pa, ha);
            if (two) ROW_DONE(m1, pb, hb);
        }
#undef ROW_LOAD
#undef ROW_DONE
    }
}
DI void conv_gate(Ctx& c, int layer) {
    const int gt = c.bx * 512 + c.tid, NT = gridDim.x * 512;
    const float* cw = c.a.in[I_CW] + (size_t)layer * 3 * DFF2; const float* cb = c.a.in[I_CB] + (size_t)layer * DFF2;
    const float* stt = c.a.in[I_SCONV] + (size_t)layer * 16 * 2 * DFF2;
    constexpr int NCO = DFF / 8, NRB = M / 16;
    const int nrg = NT / NCO;
    const int co = gt % NCO, rg = gt / NCO;
    if (rg >= nrg) return;
    const int c0 = co * 8;
    f32x2 wa[3][4], wg[3][4], ba[4], bg[4];
#pragma unroll
    for (int i = 0; i < 3; ++i)
#pragma unroll
        for (int k = 0; k < 4; ++k) { wa[i][k] = *(const f32x2*)(cw + i * DFF2 + c0 + 2 * k); wg[i][k] = *(const f32x2*)(cw + i * DFF2 + DFF + c0 + 2 * k); }
#pragma unroll
    for (int k = 0; k < 4; ++k) { ba[k] = *(const f32x2*)(cb + c0 + 2 * k); bg[k] = *(const f32x2*)(cb + DFF + c0 + 2 * k); }
    for (int rb = rg; rb < NRB; rb += nrg) {
        const int r0 = rb * 16;
        f32x2 pa[2][4], pg[2][4];
        bool zero = false, fromstate = false; int sb = 0;
        if (r0 < MPR) zero = (r0 & 4095) == 0; else { const int rs = r0 - MPR; fromstate = (rs & 31) == 0; sb = rs >> 5; }
        u32x4 xa[4], xg[4];
#pragma unroll
        for (int r = 0; r < 4; ++r) { const bf16* hp = c.HRAW + (size_t)(r0 + r) * DFF2 + c0; xa[r] = __builtin_nontemporal_load((const u32x4*)hp); xg[r] = __builtin_nontemporal_load((const u32x4*)(hp + DFF)); }
#pragma unroll
        for (int p = 0; p < 2; ++p) {
            if (zero) {
#pragma unroll
                for (int k = 0; k < 4; ++k) { pa[p][k] = (f32x2){0.f, 0.f}; pg[p][k] = (f32x2){0.f, 0.f}; }
            } else if (fromstate) { const float* sp = stt + (size_t)(sb * 2 + p) * DFF2 + c0;
#pragma unroll
                for (int k = 0; k < 4; ++k) { pa[p][k] = *(const f32x2*)(sp + 2 * k); pg[p][k] = *(const f32x2*)(sp + DFF + 2 * k); }
            } else { const bf16* hp = c.HRAW + (size_t)(r0 - 2 + p) * DFF2 + c0; const u32x4 ya = *(const u32x4*)hp, yg = *(const u32x4*)(hp + DFF);
#pragma unroll
                for (int k = 0; k < 4; ++k) { pa[p][k] = (f32x2){bflo(ya[k]), bfhi(ya[k])}; pg[p][k] = (f32x2){bflo(yg[k]), bfhi(yg[k])}; } }
        }
#pragma unroll
        for (int q = 0; q < 4; ++q) {
            u32x4 na[4], ng[4];
            if (q < 3) {
#pragma unroll
                for (int r = 0; r < 4; ++r) { const bf16* hp = c.HRAW + (size_t)(r0 + 4 * (q + 1) + r) * DFF2 + c0; na[r] = __builtin_nontemporal_load((const u32x4*)hp); ng[r] = __builtin_nontemporal_load((const u32x4*)(hp + DFF)); }
            }
#pragma unroll
            for (int r = 0; r < 4; ++r) {
                u32x4 wv;
#pragma unroll
                for (int k = 0; k < 4; ++k) {
                    const f32x2 ca = (f32x2){bflo(xa[r][k]), bfhi(xa[r][k])}, cg = (f32x2){bflo(xg[r][k]), bfhi(xg[r][k])};
                    const f32x2 av = ba[k] + pa[0][k] * wa[0][k] + pa[1][k] * wa[1][k] + ca * wa[2][k];
                    const f32x2 gv = bg[k] + pg[0][k] * wg[0][k] + pg[1][k] * wg[1][k] + cg * wg[2][k];
                    const f32x2 t = gv * (-2.3022082f + -0.10294324f * (gv * gv));
                    f32x2 d; d.x = __builtin_amdgcn_exp2f(t.x); d.y = __builtin_amdgcn_exp2f(t.y); d = d + 1.0f;
                    f32x2 rc; rc.x = __builtin_amdgcn_rcpf(d.x); rc.y = __builtin_amdgcn_rcpf(d.y);
                    const f32x2 o = (gv * rc) * av;
                    wv[k] = pk2(o.x, o.y);
                    pa[0][k] = pa[1][k]; pa[1][k] = ca; pg[0][k] = pg[1][k]; pg[1][k] = cg;
                }
                *(u32x4*)(c.ACT + (size_t)(r0 + q * 4 + r) * DFF + c0) = wv;
            }
            if (q < 3) {
#pragma unroll
                for (int r = 0; r < 4; ++r) { xa[r] = na[r]; xg[r] = ng[r]; }
            }
        }
    }
}
DI void sgate_unit(Ctx& c, int u) {
    const int tid = c.tid, w = c.wave, l15 = c.l15, quad = c.quad;
    const bool sample = u >= 512;
    int g, row0, L, sb = 0;
    if (!sample) { g = u & 7; row0 = (u >> 3) * 128; L = 128; } else { const int us = u - 512; sb = us >> 3; g = us & 7; row0 = MPR + sb * 32; L = 32; }
    LAS bf16* VN = (LAS bf16*)c.lds;
    const float* lng = c.a.in[I_LNG] + g * 256; const float* lnb = c.a.in[I_LNB] + g * 256;
    int it, ct0, nct;
    if (!sample) { it = w; ct0 = 0; nct = 16; } else { it = w & 1; ct0 = (w >> 1) * 4; nct = 4; }
    const int i = it * 16 + l15;
    bf16x8 Wf[4];
    const float* wrow = c.a.in[I_GWS] + (size_t)(g * 128 + i) * 128 + quad * 8;
#pragma unroll
    for (int s = 0; s < 4; ++s) {
        if (s * 32 <= it * 16 + 15) { float f[8]; *(f32x4*)&f[0] = *(const f32x4*)(wrow + s * 32); *(f32x4*)&f[4] = *(const f32x4*)(wrow + s * 32 + 4);
#pragma unroll
            for (int k = 0; k < 8; ++k) if (s * 32 + quad * 8 + k > i) f[k] = 0.f;
            Wf[s] = packf8(f, 1.0f); }
        else Wf[s] = (bf16x8){0, 0, 0, 0, 0, 0, 0, 0};
    }
    const float bias = c.a.in[I_GBS][g * 128 + i];
    const size_t row = (size_t)(row0 + i);
    u32x2 uw[16];
#pragma unroll
    for (int cti = 0; cti < 16; ++cti) if (cti < nct) uw[cti] = __builtin_nontemporal_load((const u32x2*)(c.UV + row * 4096 + g * 256 + (ct0 + cti) * 16 + quad * 4));
    {
        u32x4 vv[8]; float mean[8], rstd[8];
        const int c0 = (tid & 31) * 8;
        float lg[8], lb[8];
        *(f32x4*)&lg[0] = *(const f32x4*)(lng + c0); *(f32x4*)&lg[4] = *(const f32x4*)(lng + c0 + 4); *(f32x4*)&lb[0] = *(const f32x4*)(lnb + c0); *(f32x4*)&lb[4] = *(const f32x4*)(lnb + c0 + 4);
#pragma unroll
        for (int t = 0; t < 8; ++t) { const int j = (tid >> 5) + 16 * t;
            if (j < L) { const size_t row = (size_t)(row0 + j); vv[t] = __builtin_nontemporal_load((const u32x4*)(c.UV + row * 4096 + 2048 + g * 256 + c0));
                const float2 st2 = *(const float2*)(c.STATS + 2 * row); mean[t] = st2.x * (1.f / 2048.f); const float var = st2.y * (1.f / 2048.f) - mean[t] * mean[t]; rstd[t] = 1.f / sqrtf(fmaxf(var, 0.f) + EPS); } }
#pragma unroll
        for (int t = 0; t < 8; ++t) { const int j = (tid >> 5) + 16 * t;
            if (j < L) { float vn[8];
#pragma unroll
                for (int k = 0; k < 8; ++k) { const float x = (k & 1) ? bfhi(vv[t][k >> 1]) : bflo(vv[t][k >> 1]); vn[k] = (x - mean[t]) * rstd[t] * lg[k] + lb[k]; }
                { u32x4 pv; pv.x = pk2(vn[0], vn[1]); pv.y = pk2(vn[2], vn[3]); pv.z = pk2(vn[4], vn[5]); pv.w = pk2(vn[6], vn[7]); *(LAS u32x4*)(VN + j * 272 + c0) = pv; }
                if (sample) { float* go = c.a.out + O_GV + (size_t)(sb * 32 + j) * 2048 + g * 256 + c0; *(f32x4*)go = *(f32x4*)&vn[0]; *(f32x4*)(go + 4) = *(f32x4*)&vn[4]; } } }
    }
    __syncthreads();
#pragma unroll
    for (int cti = 0; cti < 16; ++cti) {
        if (cti < nct) {
            const int ct = ct0 + cti; f32x4 acc = {0.f, 0.f, 0.f, 0.f};
#pragma unroll
            for (int s = 0; s < 4; ++s) if (s * 32 <= it * 16 + 15) { const bf16x8 av = trfrag(VN, 272, s * 32 + quad * 8, s * 32 + quad * 8 + 4, ct * 16, l15); acc = MFMA16(av, Wf[s], acc); }
            const int col = g * 256 + ct * 16 + quad * 4;
            u32x2 wv; wv.x = pk2(bflo(uw[cti].x) * (acc[0] + bias), bfhi(uw[cti].x) * (acc[1] + bias)); wv.y = pk2(bflo(uw[cti].y) * (acc[2] + bias), bfhi(uw[cti].y) * (acc[3] + bias));
            *(u32x2*)(c.MIX + row * DM + col) = wv;
        }
    }
    __syncthreads();
}

#define RLX_AGENT __ATOMIC_RELAXED, __HIP_MEMORY_SCOPE_AGENT
#define XB_TMO      128
#define XB_XCNT(j)  (256  + 64 * (j))
#define XB_XSUB(j)  (1280 + 64 * (j))
#define XB_XGEN(j)  (2304 + 64 * (j))
#define XB_TOP      3328
#define XB_TOPGEN   3392
#define XCD_BAR_WORDS 3456
#define XB_SPIN_CAP (1u << 18)

__device__ __forceinline__ unsigned xb_ld(unsigned* p)              { return __hip_atomic_load(p, __ATOMIC_RELAXED, __HIP_MEMORY_SCOPE_AGENT); }
__device__ __forceinline__ unsigned xb_add(unsigned* p, unsigned v) { return __hip_atomic_fetch_add(p, v, __ATOMIC_RELAXED, __HIP_MEMORY_SCOPE_AGENT); }
__device__ __forceinline__ unsigned xb_xcc_id() { return (unsigned)__builtin_amdgcn_s_getreg((3 << 11) | 20) & 0xFu; }
#define XB_SPIN(cond, bar) do { unsigned _sp = 0; while (cond) { __builtin_amdgcn_s_sleep(1); \
    if ((++_sp & 255u) == 0u) { if (xb_ld(&(bar)[XB_TMO])) break; if (_sp > XB_SPIN_CAP) { atomicAdd(&(bar)[XB_TMO], 1u); break; } } } } while (0)

struct XcdBarrier {
    unsigned* bar; unsigned x;
    volatile LAS unsigned* st;
};

__device__ __forceinline__ XcdBarrier xcd_barrier_post(unsigned* bar, volatile LAS unsigned* st) {
    XcdBarrier b; b.bar = bar; b.x = xb_xcc_id(); b.st = st;
    if (threadIdx.x == 0) (void)xb_add(&bar[XB_XCNT(b.x)], 1u);
    return b;
}
__device__ __forceinline__ void xcd_barrier_complete(unsigned* bar, unsigned x, unsigned& nloc, unsigned& nx) {
    const unsigned G = gridDim.x * gridDim.y * gridDim.z;
    unsigned sum, cnt, mine, sp = 0u;
    for (;;) {
        sum = 0u; cnt = 0u; mine = 0u;
#pragma unroll
        for (unsigned j = 0; j < 16; ++j) { const unsigned c = xb_ld(&bar[XB_XCNT(j)]); sum += c; cnt += (c > 0u) ? 1u : 0u; mine = (j == x) ? c : mine; }
        if (sum == G) break;
        __builtin_amdgcn_s_sleep(1);
        if ((++sp & 255u) == 0u) { if (xb_ld(&bar[XB_TMO])) break; if (sp > XB_SPIN_CAP) { atomicAdd(&bar[XB_TMO], 1u); break; } }
    }
    nloc = mine > 0u ? mine : 1u; nx = cnt > 0u ? cnt : 1u;
}

__device__ __forceinline__ void xcd_barrier(const XcdBarrier& b) {
    asm volatile("s_waitcnt vmcnt(0)" ::: "memory");
    __syncthreads();
    if (threadIdx.x == 0) {
        unsigned* bar = b.bar;
        __builtin_amdgcn_s_waitcnt(0);
        unsigned nloc = b.st[0], nx = b.st[1];
        if (nloc == 0u) { xcd_barrier_complete(bar, b.x, nloc, nx); b.st[0] = nloc; b.st[1] = nx; }
        const unsigned old = xb_add(&bar[XB_XSUB(b.x)], 1u);
        const unsigned gen = old / nloc;
        if (old + 1u == (gen + 1u) * nloc) {
            __builtin_amdgcn_fence(__ATOMIC_RELEASE, "agent");
            asm volatile("s_waitcnt vmcnt(0)" ::: "memory");
            const unsigned og = xb_add(&bar[XB_TOP], 1u);
            const unsigned tg = og / nx;
            if (og + 1u == (tg + 1u) * nx) xb_add(&bar[XB_TOPGEN], 1u);
            else XB_SPIN(xb_ld(&bar[XB_TOPGEN]) == tg, bar);
            __builtin_amdgcn_fence(__ATOMIC_ACQUIRE, "agent");
            xb_add(&bar[XB_XGEN(b.x)], 1u);
            asm volatile("s_waitcnt vmcnt(0)" ::: "memory");
        } else {
            XB_SPIN(xb_ld(&bar[XB_XGEN(b.x)]) == gen, bar);
            __builtin_amdgcn_fence(__ATOMIC_ACQUIRE, "agent");
            asm volatile("s_waitcnt vmcnt(0)" ::: "memory");
        }
    }
    __syncthreads();
}

__global__ void __launch_bounds__(512, 2) mega(const float* i0, const float* i1, const float* i2, const float* i3, const float* i4, const float* i5, const float* i6, const float* i7, const float* i8, const float* i9, const float* i10, const float* i11, const float* i12, const float* i13, const float* i14, const float* i15, const float* i16, const float* i17, const float* i18, const float* i19, const float* i20, float* out_, unsigned char* ws_, int ph_lo_, int ph_hi_) {
    Args args; args.in[0] = i0; args.in[1] = i1; args.in[2] = i2; args.in[3] = i3; args.in[4] = i4; args.in[5] = i5; args.in[6] = i6; args.in[7] = i7; args.in[8] = i8; args.in[9] = i9; args.in[10] = i10; args.in[11] = i11; args.in[12] = i12; args.in[13] = i13; args.in[14] = i14; args.in[15] = i15; args.in[16] = i16; args.in[17] = i17; args.in[18] = i18; args.in[19] = i19; args.in[20] = i20; args.out = out_; args.ws = ws_; args.ph_lo = ph_lo_; args.ph_hi = ph_hi_;
    extern __shared__ __attribute__((aligned(16))) unsigned char lds_raw[];
    cg::grid_group grid = cg::this_grid();
    { volatile LAS unsigned* st0 = (volatile LAS unsigned*)((LAS unsigned char*)lds_raw + 131072); if (threadIdx.x < 64) st0[threadIdx.x] = 0u; }
    __syncthreads();
    XcdBarrier xbar = xcd_barrier_post((unsigned*)(args.ws + WS_CTL), (volatile LAS unsigned*)((LAS unsigned char*)lds_raw + 131072));
    for (int pi = args.ph_lo; pi < args.ph_hi; ++pi) {
#if defined(PROBE_A)
    const int ph = pi <= PROBE_A ? pi : (pi - 1 <= PROBE_B ? pi - 1 : pi - 2);
#else
    const int ph = pi;
#endif
    Ctx c;
    { int t_ = threadIdx.x; asm volatile("" : "+v"(t_)); c.tid = t_; }
    c.lds = (LAS unsigned char*)lds_raw; c.lane = c.tid & 63; c.wave = __builtin_amdgcn_readfirstlane(c.tid >> 6); c.l15 = c.lane & 15; c.quad = c.lane >> 4; c.a = args;
    size_t zoff = 0; asm volatile("" : "+s"(zoff));
    unsigned char* ws = args.ws + zoff;
    int bx = blockIdx.x; asm volatile("" : "+s"(bx));
    const int G = gridDim.x; c.bx = bx;
    c.Z = (bf16*)(ws + WS_Z); c.XN = (bf16*)(ws + WS_XN); c.MIX = (bf16*)(ws + WS_MIX); c.ACT = (bf16*)(ws + WS_ACT); c.HRAW = (bf16*)(ws + WS_HRAW); c.UV = (bf16*)(ws + WS_UV); c.STB = (bf16*)(ws + WS_ST); c.KP = (bf16*)(ws + WS_KP);
    c.MPB = (bf16*)(ws + WS_MPB); c.KV = (float*)(ws + WS_KV); c.COS = (float*)(ws + WS_COS); c.SIN = (float*)(ws + WS_SIN); c.STATS = (float*)(ws + WS_STATS); c.H = args.out + O_Y;
#if defined(STAGGER_TICKS)
        if ((ph == PH_WIN_E || ph == PH_UP0 || ph == PH_UP1 || ph == PH_WIN_O) && (bx & 1)) { const unsigned long long t0 = __builtin_amdgcn_s_memrealtime(); while (__builtin_amdgcn_s_memrealtime() - t0 < STAGGER_TICKS) __builtin_amdgcn_s_sleep(8); }
#endif
        if (ph == PH_PRO) prologue(c);
        else if (ph == PH_WIN_E) {
            pg8::Gemm g{c.XN, (const bf16*)(ws + WS_WINE), M, EVEN_IN, DM}; pg8::StaticOrder S; S.init(M, EVEN_IN, G, bx, DM);
            pg8::EpiBf16 E{c.Z, EVEN_IN};
            pg8::gemm_phase<pg8::EpiBf16, pg8::StaticOrder, true, true>(c.lds, g, S, E);
        } else if (ph == PH_MIXA) {
            for (int u = bx; u < 576 + 1152; u += G) { if (u < 576) swa_unit(c, u); else retkv_unit(c, u - 576); }
            swa_cache_out(c);
        } else if (ph == PH_SCAN) ret_scan(c);
        else if (ph == PH_MIXC) { for (int u = bx; u < 576; u += G) retout_pair(c, u); }
        else if (ph == PH_WOUT_E || ph == PH_WOUT_O || ph == PH_DOWN0 || ph == PH_DOWN1) {
            const bool dn = (ph == PH_DOWN0 || ph == PH_DOWN1); const int K = dn ? DFF : DM;
            const bf16* A = dn ? c.ACT : c.MIX;
            const bf16* B = ph == PH_WOUT_E ? (const bf16*)(ws + WS_WOUTE) : ph == PH_WOUT_O ? (const bf16*)(ws + WS_WOUTO) : (const bf16*)(ws + WS_WDN) + (ph == PH_DOWN1 ? (size_t)DFF * DM : 0);
            pg8::Gemm g{A, B, M, DM, K}; pg8::SplitOrder S; S.init(MPR, M - MPR, DM, K, G, bx, dn ? 11 : 16);
            pg8::EpiF32 E{c.MPB, DM, (float*)(ws + WS_PB), MPR / 256};
            pg8::gemm_phase<pg8::EpiF32, pg8::SplitOrder, true, true>(c.lds, g, S, E);
        } else if (ph == PH_UP0 || ph == PH_UP1) {
            const int L = ph == PH_UP1;
            pg8::Gemm g{c.XN, (const bf16*)(ws + WS_WUP) + (size_t)L * DFF2 * DM, M, DFF2, DM}; pg8::StaticOrder S; S.init(M, DFF2, G, bx, DM);
            pg8::EpiUp E{c.HRAW, DFF2, args.out + O_CP + (size_t)L * 2 * 2 * DFF2, args.out + O_CS + (size_t)L * 16 * 2 * DFF2};
            pg8::gemm_phase<pg8::EpiUp, pg8::StaticOrder, true, true>(c.lds, g, S, E);
        } else if (ph == PH_CONV0 || ph == PH_CONV1) conv_gate(c, ph == PH_CONV1);
        else if (ph == PH_ROWA0) row_pass(c, true, args.in[I_NORMG] + 1 * DM, args.in[I_NORMG] + 2 * DM, (const float*)(ws + WS_PB), 16);
        else if (ph == PH_ROWB0) row_pass(c, false, args.in[I_NORMG] + 3 * DM, args.in[I_NORMG] + 4 * DM, (const float*)(ws + WS_PB), 11);
        else if (ph == PH_ROWA1) row_pass(c, false, args.in[I_NORMG] + 5 * DM, args.in[I_NORMG] + 6 * DM, (const float*)(ws + WS_PB), 16);
        else if (ph == PH_ROWB1) row_pass(c, false, args.in[I_NORMG] + 7 * DM, nullptr, (const float*)(ws + WS_PB), 11);
        else if (ph == PH_WIN_O) {
            pg8::Gemm g{c.XN, (const bf16*)(ws + WS_WINO), M, 4096, DM}; pg8::StaticOrder S; S.init(M, 4096, G, bx, DM);
            pg8::EpiGeluStats E{c.UV, 4096, c.STATS, 2048};
            pg8::gemm_phase<pg8::EpiGeluStats, pg8::StaticOrder, true, true>(c.lds, g, S, E);
        } else if (ph == PH_SGATE) { for (int u = bx; u < 640; u += G) sgate_unit(c, u); }
        if (pi + 1 < args.ph_hi) { if (pi == args.ph_lo) grid.sync(); else xcd_barrier(xbar); }
    }
}

extern "C" void kernel_launch(void* const* d_in, const int* in_sizes, int n_in, void* d_out, int out_size, void* d_ws, size_t ws_size, hipStream_t stream) {
    static int grid = 0;
    if (grid == 0) {
        if (n_in != 21 || (size_t)out_size != O_END || ws_size < WS_END) { fprintf(stderr, "kernel_launch: unexpected shapes: n_in %d out %d ws %zu\n", n_in, out_size, ws_size); grid = -1; return; }
        int dev = 0, cus = 0, per_cu = 0;
        hipGetDevice(&dev); hipDeviceGetAttribute(&cus, hipDeviceAttributeMultiprocessorCount, dev);
        hipFuncSetAttribute((const void*)mega, hipFuncAttributeMaxDynamicSharedMemorySize, LDS_BYTES);
        if (hipOccupancyMaxActiveBlocksPerMultiprocessor(&per_cu, (const void*)mega, 512, LDS_BYTES) != hipSuccess || per_cu < 1) { fprintf(stderr, "kernel_launch: occupancy query says %d\n", per_cu); per_cu = 1; }
        (void)hipGetLastError();
        grid = cus * 1;
    }
    if (grid < 0) return;
    hipMemsetAsync((char*)d_ws + WS_CTL, 0, CTL_BYTES, stream);
    Args a{};
    for (int i = 0; i < 21; ++i) a.in[i] = (const float*)d_in[i];
    a.out = (float*)d_out; a.ws = (unsigned char*)d_ws;
#if ONE_LAUNCH
#if defined(PROBE_A)
    a.ph_lo = 0; a.ph_hi = NPH + 1 + (PROBE_B < NPH ? 1 : 0);
#else
    a.ph_lo = 0; a.ph_hi = NPH;
#endif
    void* kargs[25]; for (int i = 0; i < 21; ++i) kargs[i] = (void*)&a.in[i];
    kargs[21] = (void*)&a.out; kargs[22] = (void*)&a.ws; kargs[23] = (void*)&a.ph_lo; kargs[24] = (void*)&a.ph_hi;
    hipError_t e = hipLaunchCooperativeKernel((const void*)mega, dim3(grid), dim3(512), kargs, LDS_BYTES, stream);
    if (e != hipSuccess) fprintf(stderr, "cooperative launch failed: %s (grid %d)\n", hipGetErrorString(e), grid);
#else
    for (int ph = 0; ph < NPH; ++ph) { hipLaunchKernelGGL(mega, dim3(grid), dim3(512), LDS_BYTES, stream, a.in[0], a.in[1], a.in[2], a.in[3], a.in[4], a.in[5], a.in[6], a.in[7], a.in[8], a.in[9], a.in[10], a.in[11], a.in[12], a.in[13], a.in[14], a.in[15], a.in[16], a.in[17], a.in[18], a.in[19], a.in[20], a.out, a.ws, ph, ph + 1); }
#endif
}
```

```cpp
#include <hip/hip_runtime.h>
#include <hip/hip_cooperative_groups.h>
#include <cstdio>
#include <cstdint>
namespace cg = cooperative_groups;
#ifndef ONE_LAUNCH
#define ONE_LAUNCH 1
#endif
namespace pg8 {
#define PG8_LAS __attribute__((address_space(3)))
typedef unsigned short bf16_t;
typedef short bf16x8 __attribute__((ext_vector_type(8)));
typedef float f32x4 __attribute__((ext_vector_type(4)));
typedef unsigned u32x4 __attribute__((ext_vector_type(4)));
constexpr int BM = 256, BK = 64, HALF = 128, HTB = HALF * BK * 2  , STAGE_BYTES = 8 * HTB, NXCD = 8, WGM = 8;

__host__ __device__ __forceinline__ int lds_byte(int r, int c) { const int st = (r >> 4) * 2 + (c >> 5), rr = r & 15, cc = c & 31, ob = rr * 64 + cc * 2; return st * 1024 + (ob ^ (((ob >> 9) & 1) << 5)); }
__host__ __device__ __forceinline__ void stage_rc(int b, int& R, int& C) { const int st = b / 1024, sb = b % 1024, swz = sb ^ (((sb >> 9) & 1) << 5); R = (st >> 1) * 16 + swz / 64; C = (st & 1) * 32 + (swz % 64) / 2; }
__host__ __device__ __forceinline__ int perm32(int rho) { const int n = rho >> 4, i = rho & 15; return 8 * (i >> 2) + 4 * n + (i & 3); }

struct Unit { int pm, pn, k0, nt, split; };
struct Gemm { const bf16_t* A; const bf16_t* Bt; int M, N, K; };

struct StaticOrder {
    int nM, nN, nwg, G, c, ntk;
    __host__ __device__ void init(int M, int N, int G_, int c_, int K) { nM = M / BM; nN = N / BM; nwg = nM * nN; G = G_; c = c_; ntk = K / BK; }
    __host__ __device__ __forceinline__ bool next(int i, Unit& u) const {
        const long L = (long)i * G + c; if (L >= nwg) return false;
        int wgid = (int)L; { const int q = nwg / NXCD, r = nwg % NXCD, xcd = wgid % NXCD, off = wgid / NXCD; wgid = (xcd < r ? xcd * (q + 1) : r * (q + 1) + (xcd - r) * q) + off; }
        const int nig = WGM * nN, gid = wgid / nig, fm = gid * WGM, gsz = (nM - fm) < WGM ? (nM - fm) : WGM;
        u.pm = fm + ((wgid % nig) % gsz); u.pn = (wgid % nig) / gsz; u.k0 = 0; u.nt = ntk; u.split = 0; return true;
    }
    __device__ __forceinline__ void a_ready(const Unit&) const {}
    __device__ __forceinline__ void done(const Unit&) const {}
};
struct SplitOrder {
    StaticOrder so; int np, G, c, S, ntk, nN, pm0, nsplit;
    __host__ __device__ void init(int Mp, int Ms, int N, int K, int G_, int c_, int S_) { so.init(Mp, N, G_, c_, K); G = G_; c = c_; S = S_; ntk = K / BK; nN = N / BM; pm0 = Mp / BM; nsplit = (Ms / BM) * nN * S;
        np = so.nwg > c ? (so.nwg - c + G - 1) / G : 0; }
    __host__ __device__ __forceinline__ bool next(int i, Unit& u) const {
        if ((c & 1) && np == 1 && nsplit <= G && c < nsplit && i < 2) i = 1 - i;
        Unit p; p.pm = 0; p.pn = 0; p.k0 = 0; p.nt = ntk; p.split = 0;
        const bool okp = (i < np) ? so.next(i, p) : false;
        const int Ls = (i - np) * G + c; const bool oks = (i >= np) && (Ls < nsplit);
        const int tile = Ls / S, ks = Ls % S, nts = ntk / S;
        u.pm = oks ? pm0 + tile / nN : p.pm; u.pn = oks ? tile % nN : p.pn; u.nt = oks ? nts : p.nt; u.k0 = oks ? ks * nts : p.k0; u.split = oks ? 1 : 0;
        return okp || oks;
    }
    __device__ __forceinline__ void a_ready(const Unit&) const {}
    __device__ __forceinline__ void done(const Unit&) const {}
};


__device__ __forceinline__ unsigned cvt_pk_bf16(float lo, float hi) { unsigned r; asm volatile("v_cvt_pk_bf16_f32 %0, %1, %2" : "=v"(r) : "v"(lo), "v"(hi)); return r; }
typedef float f32x2 __attribute__((ext_vector_type(2)));
__device__ __forceinline__ float gelu_tanh(float x) { const float t = x * (-2.3022082f + -0.10294324f * (x * x)); return x * __builtin_amdgcn_rcpf(1.f + __builtin_amdgcn_exp2f(t)); }
struct EpiBf16 {
    static constexpr bool PERM = true, AFTER_DRAIN = false;
    bf16_t* O; int ldc;
    __device__ __forceinline__ void operator()(const f32x4 (&acc)[2][2][4][2], const Unit& u, int wr, int wc, int fr, int fq) const {
        const int row0 = u.pm * BM + wr * 64 + fr, col0 = u.pn * BM + wc * 32 + 8 * fq;
#pragma unroll
        for (int ai = 0; ai < 2; ++ai)
#pragma unroll
            for (int m = 0; m < 4; ++m) { bf16_t* rowp = O + (size_t)(row0 + ai * HALF + m * 16) * ldc + col0;
#pragma unroll
                for (int bj = 0; bj < 2; ++bj) { const f32x4 v0 = acc[ai][bj][m][0], v1 = acc[ai][bj][m][1];
                    u32x4 w; w.x = cvt_pk_bf16(v0[0], v0[1]); w.y = cvt_pk_bf16(v0[2], v0[3]); w.z = cvt_pk_bf16(v1[0], v1[1]); w.w = cvt_pk_bf16(v1[2], v1[3]);
                    *(u32x4*)(rowp + bj * HALF) = w; } }
    }
};
struct EpiUp {
    static constexpr bool PERM = true, AFTER_DRAIN = false;
    bf16_t* O; int ldc; float* cp; float* cs;
    __device__ __forceinline__ void operator()(const f32x4 (&acc)[2][2][4][2], const Unit& u, int wr, int wc, int fr, int fq) const {
        const int row0 = u.pm * BM + wr * 64 + fr, col0 = u.pn * BM + wc * 32 + 8 * fq;
        const bool may = (u.pm >= 32) || ((u.pm & 15) == 15);
#pragma unroll
        for (int ai = 0; ai < 2; ++ai)
#pragma unroll
            for (int m = 0; m < 4; ++m) { const int row = row0 + ai * HALF + m * 16; bf16_t* rowp = O + (size_t)row * ldc + col0;
                float* so = nullptr;
                if (may) {
                    if (row < 8192) { const int t = row & 4095; if (t >= 4094) so = cp + (size_t)((row >> 12) * 2 + (t - 4094)) * ldc + col0; }
                    else { const int rs = row - 8192, t = rs & 31; if (t >= 30) so = cs + (size_t)((rs >> 5) * 2 + (t - 30)) * ldc + col0; } }
#pragma unroll
                for (int bj = 0; bj < 2; ++bj) { const f32x4 v0 = acc[ai][bj][m][0], v1 = acc[ai][bj][m][1];
                    u32x4 w; w.x = cvt_pk_bf16(v0[0], v0[1]); w.y = cvt_pk_bf16(v0[2], v0[3]); w.z = cvt_pk_bf16(v1[0], v1[1]); w.w = cvt_pk_bf16(v1[2], v1[3]);
                    *(u32x4*)(rowp + bj * HALF) = w;
                    if (so) { *(f32x4*)(so + bj * HALF) = v0; *(f32x4*)(so + bj * HALF + 4) = v1; } } }
    }
};
struct EpiF32 {
    static constexpr bool PERM = true, AFTER_DRAIN = false;
    bf16_t* O; int ldc; float* PB; int pm0;
    __device__ __forceinline__ void operator()(const f32x4 (&acc)[2][2][4][2], const Unit& u, int wr, int wc, int fr, int fq) const {
        const int row0 = u.pm * BM + wr * 64 + fr, col0 = u.pn * BM + wc * 32 + 8 * fq;
        if (!u.split) {
#pragma unroll
            for (int ai = 0; ai < 2; ++ai)
#pragma unroll
                for (int m = 0; m < 4; ++m) { bf16_t* rowp = O + (size_t)(row0 + ai * HALF + m * 16) * ldc + col0;
#pragma unroll
                    for (int bj = 0; bj < 2; ++bj) { const f32x4 v0 = acc[ai][bj][m][0], v1 = acc[ai][bj][m][1];
                        u32x4 w; w.x = cvt_pk_bf16(v0[0], v0[1]); w.y = cvt_pk_bf16(v0[2], v0[3]); w.z = cvt_pk_bf16(v1[0], v1[1]); w.w = cvt_pk_bf16(v1[2], v1[3]);
                        *(u32x4*)(rowp + bj * HALF) = w; } }
        } else {
            bf16_t* base = (bf16_t*)PB + ((size_t)(u.k0 / u.nt) * 512 - (size_t)pm0 * BM) * ldc;
#pragma unroll
            for (int ai = 0; ai < 2; ++ai)
#pragma unroll
                for (int m = 0; m < 4; ++m) { bf16_t* rowp = base + (size_t)(row0 + ai * HALF + m * 16) * ldc + col0;
#pragma unroll
                    for (int bj = 0; bj < 2; ++bj) { const f32x4 v0 = acc[ai][bj][m][0], v1 = acc[ai][bj][m][1];
                        u32x4 w; w.x = cvt_pk_bf16(v0[0], v0[1]); w.y = cvt_pk_bf16(v0[2], v0[3]); w.z = cvt_pk_bf16(v1[0], v1[1]); w.w = cvt_pk_bf16(v1[2], v1[3]);
                        *(u32x4*)(rowp + bj * HALF) = w; } }
        }
    }
};
struct EpiGeluStats {
    static constexpr bool PERM = true, AFTER_DRAIN = false;
    bf16_t* O; int ldc; float* stats; int vcol0;
    __device__ __forceinline__ void operator()(const f32x4 (&acc)[2][2][4][2], const Unit& u, int wr, int wc, int fr, int fq) const {
        const int row0 = u.pm * BM + wr * 64 + fr, col0 = u.pn * BM + wc * 32 + 8 * fq;
        const bool isv = u.pn * BM >= vcol0;
#pragma unroll
        for (int ai = 0; ai < 2; ++ai)
#pragma unroll
            for (int m = 0; m < 4; ++m) { const int row = row0 + ai * HALF + m * 16; bf16_t* rowp = O + (size_t)row * ldc + col0;
                float s = 0.f, q = 0.f;
#pragma unroll
                for (int bj = 0; bj < 2; ++bj) { f32x4 v0 = acc[ai][bj][m][0], v1 = acc[ai][bj][m][1];
#pragma unroll
                    for (int e = 0; e < 4; ++e) { v0[e] = gelu_tanh(v0[e]); v1[e] = gelu_tanh(v1[e]); s += v0[e] + v1[e]; q += v0[e] * v0[e] + v1[e] * v1[e]; }
                    u32x4 w; w.x = cvt_pk_bf16(v0[0], v0[1]); w.y = cvt_pk_bf16(v0[2], v0[3]); w.z = cvt_pk_bf16(v1[0], v1[1]); w.w = cvt_pk_bf16(v1[2], v1[3]);
                    *(u32x4*)(rowp + bj * HALF) = w; }
                if (isv) { s += __shfl_xor(s, 16); s += __shfl_xor(s, 32); q += __shfl_xor(q, 16); q += __shfl_xor(q, 32);
                    if (fq == 0) { unsafeAtomicAdd(stats + 2 * row, s); unsafeAtomicAdd(stats + 2 * row + 1, q); } } }
    }
};
template <class Epi, class Sched, bool ALIGN_EPI = false, bool SP2 = false>
__device__ __forceinline__ void gemm_phase(PG8_LAS unsigned char* lds, const Gemm g, const Sched& S, const Epi& E) {
    int tid_ = threadIdx.x; asm volatile("" : "+v"(tid_)); const int tid = tid_, wid = __builtin_amdgcn_readfirstlane(tid >> 6), lane = tid & 63, wr = wid >> 2, wc = wid & 3, fr = lane & 15, fq = lane >> 4;
    const int K = g.K, nt = K / BK;
    unsigned voffA[2], voffB[2];
#pragma unroll
    for (int i = 0; i < 2; ++i) { int R, C; stage_rc(tid * 16 + i * 8192, R, C); const int Rb = Epi::PERM ? ((R & ~31) + perm32(R & 31)) : R;
        voffA[i] = (unsigned)(R * K + C) * 2u; voffB[i] = (unsigned)(Rb * K + C) * 2u; }
    const size_t kstep = (size_t)(BK * 2);
    const size_t hstep = (size_t)HALF * K * 2;
    const size_t tstep = 2 * hstep;
    const unsigned ldsw = (unsigned)wid * 1024u;
    const int aoff = lds_byte(wr * 64 + fr, fq * 8), boff = lds_byte(wc * 32 + fr, fq * 8);
#define PG8_SA(b, h) (((b) * 2 + (h)) * HTB)
#define PG8_SB(b, h) ((4 + (b) * 2 + (h)) * HTB)
#define PG8_STAGE(bufoff, gbase, voff) do { _Pragma("unroll") for (int _i = 0; _i < 2; ++_i) \
        __builtin_amdgcn_global_load_lds((const unsigned*)((const char*)(gbase) + (voff)[_i]), (PG8_LAS unsigned*)(lds + (bufoff) + ldsw + _i * 8192), 16, 0, 0); } while (0)
#define PG8_LDA(dst, b, h) do { _Pragma("unroll") for (int m = 0; m < 4; ++m) _Pragma("unroll") for (int k = 0; k < 2; ++k) dst[m][k] = *(const PG8_LAS bf16x8*)(lds + PG8_SA(b, h) + aoff + m * 2048 + k * 1024); } while (0)
#define PG8_LDB(dst, b, h) do { _Pragma("unroll") for (int n = 0; n < 2; ++n) _Pragma("unroll") for (int k = 0; k < 2; ++k) dst[n][k] = *(const PG8_LAS bf16x8*)(lds + PG8_SB(b, h) + boff + n * 2048 + k * 1024); } while (0)
#define PG8_MMA(ai, bj, At, Bt) do { __builtin_amdgcn_s_setprio(1); _Pragma("unroll") for (int m = 0; m < 4; ++m) _Pragma("unroll") for (int n = 0; n < 2; ++n) _Pragma("unroll") for (int k = 0; k < 2; ++k) \
        acc[ai][bj][m][n] = __builtin_amdgcn_mfma_f32_16x16x32_bf16(Bt[n][k], At[m][k], acc[ai][bj][m][n], 0, 0, 0); __builtin_amdgcn_s_setprio(0); } while (0)
#define PG8_WAIT_V(n) asm volatile("s_waitcnt vmcnt(" #n ")" ::: "memory")
#define PG8_WAIT_L(n) asm volatile("s_waitcnt lgkmcnt(" #n ")" ::: "memory")
#define PG8_BAR __builtin_amdgcn_s_barrier()
#define PG8_SCHED __builtin_amdgcn_sched_barrier(0)
    Unit cur, nxt; int ui = 0;
    if (!S.next(0, cur)) return;
    f32x4 acc[2][2][4][2];
#pragma unroll
    for (int a = 0; a < 2; ++a)
#pragma unroll
        for (int b = 0; b < 2; ++b)
#pragma unroll
            for (int m = 0; m < 4; ++m)
#pragma unroll
                for (int n = 0; n < 2; ++n) acc[a][b][m][n] = (f32x4){0.f, 0.f, 0.f, 0.f};
    bf16x8 At[4][2], B0[2][2], B1[2][2];
    const char* cA = (const char*)g.A + (size_t)cur.pm * tstep + (size_t)cur.k0 * kstep; const char* cB = (const char*)g.Bt + (size_t)cur.pn * tstep + (size_t)cur.k0 * kstep;
    S.a_ready(cur);
    if constexpr (SP2) {
        PG8_STAGE(PG8_SB(0, 0), cB, voffB); PG8_STAGE(PG8_SB(0, 1), cB + hstep, voffB); PG8_STAGE(PG8_SA(0, 0), cA, voffA); PG8_STAGE(PG8_SA(0, 1), cA + hstep, voffA);
        if (wr == 1) PG8_BAR;
        PG8_WAIT_V(2); PG8_BAR;
        PG8_STAGE(PG8_SB(1, 0), cB + kstep, voffB); PG8_STAGE(PG8_SA(1, 0), cA + kstep, voffA); PG8_STAGE(PG8_SB(1, 1), cB + hstep + kstep, voffB);
        PG8_WAIT_V(6); PG8_BAR;
    } else {
        PG8_STAGE(PG8_SB(0, 0), cB, voffB); PG8_STAGE(PG8_SA(0, 0), cA, voffA); PG8_STAGE(PG8_SB(0, 1), cB + hstep, voffB); PG8_STAGE(PG8_SA(0, 1), cA + hstep, voffA);
        if (wr == 1) PG8_BAR;
        PG8_WAIT_V(4); PG8_BAR;
        PG8_STAGE(PG8_SB(1, 0), cB + kstep, voffB); PG8_STAGE(PG8_SA(1, 0), cA + kstep, voffA); PG8_STAGE(PG8_SB(1, 1), cB + hstep + kstep, voffB);
        PG8_WAIT_V(6); PG8_BAR;
    }
    for (;;) {
        const bool has_next = S.next(ui + 1, nxt);
        const char* nA = has_next ? (const char*)g.A + (size_t)nxt.pm * tstep + (size_t)nxt.k0 * kstep : cA; const char* nB = has_next ? (const char*)g.Bt + (size_t)nxt.pn * tstep + (size_t)nxt.k0 * kstep : cB;
        const int cnt = cur.nt;
        for (int t = 0; t < cnt; t += 2) {
            const bool last = (t == cnt - 2);
            const char* a1 = cA + (size_t)(t + 1) * kstep;
            const char* a2 = last ? nA : cA + (size_t)(t + 2) * kstep; const char* b2 = last ? nB : cB + (size_t)(t + 2) * kstep;
            const char* a3 = a2 + kstep; const char* b3 = b2 + kstep;
            if (last && has_next) S.a_ready(nxt);
            if constexpr (SP2) {
            PG8_LDB(B0, 0, 0); PG8_LDB(B1, 0, 1); PG8_SCHED; PG8_LDA(At, 0, 0); PG8_STAGE(PG8_SA(1, 1), a1 + hstep, voffA);
            PG8_WAIT_V(8); PG8_WAIT_L(0); PG8_BAR; PG8_MMA(0, 0, At, B0); PG8_MMA(0, 1, At, B1); PG8_BAR; PG8_SCHED;
            PG8_LDA(At, 0, 1); PG8_STAGE(PG8_SB(0, 0), b2, voffB); PG8_STAGE(PG8_SB(0, 1), b2 + hstep, voffB); PG8_STAGE(PG8_SA(0, 0), a2, voffA);
            PG8_WAIT_V(8); PG8_WAIT_L(0); PG8_BAR; PG8_MMA(1, 0, At, B0); PG8_MMA(1, 1, At, B1); PG8_BAR; PG8_SCHED;
            PG8_LDB(B0, 1, 0); PG8_LDB(B1, 1, 1); PG8_SCHED; PG8_LDA(At, 1, 0); PG8_STAGE(PG8_SA(0, 1), a2 + hstep, voffA);
            PG8_WAIT_V(8); PG8_WAIT_L(0); PG8_BAR; PG8_MMA(0, 0, At, B0); PG8_MMA(0, 1, At, B1); PG8_BAR; PG8_SCHED;
            PG8_LDA(At, 1, 1); PG8_STAGE(PG8_SB(1, 0), b3, voffB); PG8_STAGE(PG8_SB(1, 1), b3 + hstep, voffB); PG8_STAGE(PG8_SA(1, 0), a3, voffA);
            PG8_WAIT_V(8); PG8_WAIT_L(0); PG8_BAR; PG8_MMA(1, 0, At, B0); PG8_MMA(1, 1, At, B1); PG8_BAR; PG8_SCHED;
            } else {
            PG8_LDB(B0, 0, 0); PG8_SCHED; PG8_LDA(At, 0, 0); PG8_STAGE(PG8_SA(1, 1), a1 + hstep, voffA);
            PG8_WAIT_L(8); PG8_BAR; PG8_WAIT_L(0); PG8_MMA(0, 0, At, B0); PG8_BAR; PG8_SCHED;
            PG8_LDB(B1, 0, 1); PG8_STAGE(PG8_SB(0, 0), b2, voffB);
            PG8_BAR; PG8_WAIT_L(0); PG8_MMA(0, 1, At, B1); PG8_BAR;
            PG8_LDA(At, 0, 1); PG8_STAGE(PG8_SA(0, 0), a2, voffA);
            PG8_BAR; PG8_WAIT_L(0); PG8_MMA(1, 0, At, B0); PG8_BAR; PG8_SCHED;
            PG8_STAGE(PG8_SB(0, 1), b2 + hstep, voffB);
            PG8_WAIT_V(6); PG8_BAR; PG8_MMA(1, 1, At, B1); PG8_BAR;
            PG8_LDB(B0, 1, 0); PG8_SCHED; PG8_LDA(At, 1, 0); PG8_STAGE(PG8_SA(0, 1), a2 + hstep, voffA);
            PG8_WAIT_L(8); PG8_BAR; PG8_WAIT_L(0); PG8_MMA(0, 0, At, B0); PG8_BAR; PG8_SCHED;
            PG8_LDB(B1, 1, 1); PG8_STAGE(PG8_SB(1, 0), b3, voffB);
            PG8_BAR; PG8_WAIT_L(0); PG8_MMA(0, 1, At, B1); PG8_BAR;
            PG8_LDA(At, 1, 1); PG8_STAGE(PG8_SA(1, 0), a3, voffA);
            PG8_BAR; PG8_WAIT_L(0); PG8_MMA(1, 0, At, B0); PG8_BAR; PG8_SCHED;
            PG8_STAGE(PG8_SB(1, 1), b3 + hstep, voffB);
            PG8_WAIT_V(6); PG8_BAR; PG8_MMA(1, 1, At, B1); PG8_BAR;
            }
        }
        if constexpr (ALIGN_EPI) { if (wr == 0) PG8_BAR; }
        if constexpr (!Epi::AFTER_DRAIN) { E(acc, cur, wr, wc, fr, fq); S.done(cur); }
        if (!has_next) break;
#pragma unroll
        for (int a = 0; a < 2; ++a)
#pragma unroll
            for (int b = 0; b < 2; ++b)
#pragma unroll
                for (int m = 0; m < 4; ++m)
#pragma unroll
                    for (int n = 0; n < 2; ++n) acc[a][b][m][n] = (f32x4){0.f, 0.f, 0.f, 0.f};
        cur = nxt; cA = nA; cB = nB; ++ui;
        if constexpr (ALIGN_EPI) { if (wr == 1) PG8_BAR; }
    }
    PG8_WAIT_V(0);
    if constexpr (!ALIGN_EPI) { if (wr == 0) PG8_BAR; }
    PG8_BAR;
    if constexpr (Epi::AFTER_DRAIN) { E.fused(acc, cur, wr, wc, fr, fq, lds, wid, lane); S.done(cur); }
#undef PG8_SA
#undef PG8_SB
#undef PG8_STAGE
#undef PG8_LDA
#undef PG8_LDB
#undef PG8_MMA
#undef PG8_WAIT_V
#undef PG8_WAIT_L
#undef PG8_BAR
#undef PG8_SCHED
}
}
#define DI __device__ __forceinline__
#define LAS __attribute__((address_space(3)))
typedef unsigned short bf16;
typedef float f32x4 __attribute__((ext_vector_type(4)));
typedef short bf16x8 __attribute__((ext_vector_type(8)));
typedef short s16x4 __attribute__((ext_vector_type(4)));
typedef unsigned u32x4 __attribute__((ext_vector_type(4)));
typedef unsigned u32x2 __attribute__((ext_vector_type(2)));
typedef float f32x2 __attribute__((ext_vector_type(2)));
#define MFMA16(a, b, c) __builtin_amdgcn_mfma_f32_16x16x32_bf16((a), (b), (c), 0, 0, 0)

constexpr int DM = 2048, MPR = 8192, M = 8704, EVEN_IN = 5632, DFF = 5632, DFF2 = 11264;
constexpr int ZQ = 0, ZK = 1024, ZV = 1280, ZRQ = 1536, ZRK = 2560, ZRV = 3584, ZRG = 4608;
constexpr float EPS = 1e-6f;
constexpr size_t O_Y = 0, O_KP = 17825792, O_VP = 17891328, O_RP = 17956864, O_CP = 18219008, O_KS = 18309120, O_VS = 18833408,
                 O_RS = 19357696, O_CS = 21454848, O_GV = 22175744, O_END = 23224320;
constexpr size_t MiB = 1u << 20;
constexpr size_t WS_CTL = 0, CTL_BYTES = 1 * MiB, WS_STATS = 65536;
constexpr size_t WS_COS = 1 * MiB, WS_SIN = 2 * MiB;
constexpr size_t WS_WINE = 3 * MiB, WS_WOUTE = 25 * MiB, WS_WINO = 33 * MiB, WS_WOUTO = 49 * MiB, WS_WUP = 57 * MiB, WS_WDN = 145 * MiB;
constexpr size_t WS_XN = 189 * MiB, WS_MIX = 223 * MiB, WS_MPB = 257 * MiB, WS_ACT = 325 * MiB, WS_A = 419 * MiB, WS_PB = 609 * MiB, WS_KP = 653 * MiB, WS_END = 671 * MiB;
constexpr size_t WS_Z = WS_A, WS_KV = WS_A + 94 * MiB, WS_ST = WS_A + 158 * MiB, WS_HRAW = WS_A, WS_UV = WS_A;
constexpr int LDS_BYTES = 131072 + 1024;

enum { PH_PRO = 0, PH_WIN_E, PH_MIXA, PH_SCAN, PH_MIXC, PH_WOUT_E, PH_ROWA0, PH_UP0, PH_CONV0, PH_DOWN0, PH_ROWB0,
       PH_WIN_O, PH_SGATE, PH_WOUT_O, PH_ROWA1, PH_UP1, PH_CONV1, PH_DOWN1, PH_ROWB1, NPH };

struct Args { const float* in[21]; float* out; unsigned char* ws; int ph_lo, ph_hi; };
enum { I_XP = 0, I_XS, I_CK, I_CV, I_SRET, I_SCONV, I_NORMG, I_WINE, I_WOUTE, I_SINK, I_RETG, I_WINO, I_WOUTO, I_LNG, I_LNB, I_GWS, I_GBS, I_WUP, I_CW, I_CB, I_WDN };

DI unsigned f2bf(float f) { unsigned u = __builtin_bit_cast(unsigned, f); return (u + 0x7fffu + ((u >> 16) & 1u)) >> 16; }
DI unsigned pk2(float lo, float hi) { unsigned r; asm volatile("v_cvt_pk_bf16_f32 %0, %1, %2" : "=v"(r) : "v"(lo), "v"(hi)); return r; }
DI float bflo(unsigned u) { return __builtin_bit_cast(float, u << 16); }
DI float bfhi(unsigned u) { return __builtin_bit_cast(float, u & 0xffff0000u); }
DI float wave_sum(float v) {
#pragma unroll
    for (int o = 1; o < 64; o <<= 1) v += __shfl_xor(v, o);
    return v;
}
typedef short v4i16_t __attribute__((ext_vector_type(4)));
DI s16x4 trd(const LAS bf16* p) { return __builtin_bit_cast(s16x4, __builtin_amdgcn_ds_read_tr16_b64_v4i16((LAS v4i16_t*)p)); }
DI bf16x8 trfrag(const LAS bf16* img, int pitch, int krowA, int krowB, int col0, int l15) {
    const int q = l15 >> 2, p = l15 & 3;
    const s16x4 lo = trd(img + (krowA + q) * pitch + col0 + 4 * p), hi = trd(img + (krowB + q) * pitch + col0 + 4 * p);
    return __builtin_shufflevector(lo, hi, 0, 1, 2, 3, 4, 5, 6, 7);
}
DI float dot4(f32x4 a) { return (a.x * a.x + a.y * a.y) + (a.z * a.z + a.w * a.w); }

struct Ctx {
    LAS unsigned char* lds; int tid, lane, wave, l15, quad, bx; Args a;
    bf16 *Z, *XN, *MIX, *ACT, *HRAW, *UV, *STB, *KP; float *KV, *COS, *SIN, *STATS, *H; bf16* MPB;
};

struct TItem { const float* src; bf16* dst; int N, K; };
DI void t_load(const TItem& t, float (&tv)[32], int lane) {
#pragma unroll
    for (int i = 0; i < 8; ++i) *(f32x4*)&tv[4 * i] = __builtin_nontemporal_load((const f32x4*)(t.src + (size_t)(8 * i + (lane >> 3)) * t.N + (lane & 7) * 4));
}
DI void t_store(const TItem& t, const float (&tv)[32], LAS float* scr, int lane) {
#pragma unroll
    for (int i = 0; i < 8; ++i)
#pragma unroll
        for (int e2 = 0; e2 < 4; ++e2) scr[(8 * i + (lane >> 3)) * 33 + (lane & 7) * 4 + e2] = tv[4 * i + e2];
    asm volatile("s_waitcnt lgkmcnt(0)" ::: "memory");
    const int cc = lane & 7;
#pragma unroll
    for (int j = 0; j < 4; ++j) { const int n = (lane >> 3) + 8 * j; const LAS float* s = scr + (8 * cc) * 33 + n;
        u32x4 o; o.x = pk2(s[0 * 33], s[1 * 33]); o.y = pk2(s[2 * 33], s[3 * 33]); o.z = pk2(s[4 * 33], s[5 * 33]); o.w = pk2(s[6 * 33], s[7 * 33]);
        *(u32x4*)(t.dst + (size_t)n * t.K + 8 * cc) = o; }
    asm volatile("s_waitcnt lgkmcnt(0)" ::: "memory");
}
DI void rms_row_to_bf16(const float* xrow, const float* g, bf16* orow, int lane) {
    f32x4 v[8]; float s = 0.f;
#pragma unroll
    for (int j = 0; j < 8; ++j) { v[j] = __builtin_nontemporal_load((const f32x4*)xrow + lane + 64 * j); s += dot4(v[j]); }
    const float r = 1.f / sqrtf(wave_sum(s) * (1.f / DM) + EPS);
#pragma unroll
    for (int j = 0; j < 8; ++j) { const f32x4 gg = ((const f32x4*)g)[lane + 64 * j]; const f32x4 o = v[j] * r * gg;
        u32x2 w; w.x = pk2(o.x, o.y); w.y = pk2(o.z, o.w); ((u32x2*)orow)[lane + 64 * j] = w; }
}
DI void prologue(Ctx& c) {
    LAS float* scr = (LAS float*)(c.lds + c.wave * 16384);
    const int gw = c.bx * 8 + c.wave, NGW = gridDim.x * 8;
    unsigned char* ws = c.a.ws;
    constexpr int I0 = 32 * 176, I1 = 32 * 64, I2 = 32 * 128, I3 = 32 * 64, I4 = 32 * 352, I5 = 88 * 64;
    constexpr int NIT = I0 + I1 + I2 + I3 + 2 * I4 + 2 * I5;
#define T_DECODE(t, it_) do { int r_ = (it_); const float* W_; bf16* D_; int K_, N_; \
        if (r_ < I0) { W_ = c.a.in[I_WINE]; D_ = (bf16*)(ws + WS_WINE); K_ = 2048; N_ = 5632; } \
        else if ((r_ -= I0) < I1) { W_ = c.a.in[I_WOUTE]; D_ = (bf16*)(ws + WS_WOUTE); K_ = 2048; N_ = 2048; } \
        else if ((r_ -= I1) < I2) { W_ = c.a.in[I_WINO]; D_ = (bf16*)(ws + WS_WINO); K_ = 2048; N_ = 4096; } \
        else if ((r_ -= I2) < I3) { W_ = c.a.in[I_WOUTO]; D_ = (bf16*)(ws + WS_WOUTO); K_ = 2048; N_ = 2048; } \
        else if ((r_ -= I3) < 2 * I4) { const int L_ = r_ / I4; r_ -= L_ * I4; W_ = c.a.in[I_WUP] + (size_t)L_ * 2048 * 11264; D_ = (bf16*)(ws + WS_WUP) + (size_t)L_ * 2048 * 11264; K_ = 2048; N_ = 11264; } \
        else { r_ -= 2 * I4; const int L_ = r_ / I5; r_ -= L_ * I5; W_ = c.a.in[I_WDN] + (size_t)L_ * 5632 * 2048; D_ = (bf16*)(ws + WS_WDN) + (size_t)L_ * 5632 * 2048; K_ = 5632; N_ = 2048; } \
        const int nblk_ = N_ / 32, q_ = r_ >> 3, w8_ = r_ & 7, kb_ = 2 * (q_ / (nblk_ / 4)) + (w8_ >> 2), nb_ = 4 * (q_ % (nblk_ / 4)) + (w8_ & 3);     \
        (t).src = W_ + (size_t)(64 * kb_) * N_ + 32 * nb_; (t).dst = D_ + (size_t)(32 * nb_) * K_ + 64 * kb_; (t).N = N_; (t).K = K_; } while (0)
    {
        TItem ta, tb; float va[32], vb[32];
        int it = gw;
        if (it < NIT) { T_DECODE(ta, it); t_load(ta, va, c.lane); }
        for (; it < NIT; it += 2 * NGW) {
            const int i2 = it + NGW; const bool h2 = i2 < NIT;
            if (h2) { T_DECODE(tb, i2); t_load(tb, vb, c.lane); }
            t_store(ta, va, scr, c.lane);
            const int i3 = i2 + NGW;
            if (i3 < NIT) { T_DECODE(ta, i3); t_load(ta, va, c.lane); }
            if (h2) t_store(tb, vb, scr, c.lane);
        }
    }
#undef T_DECODE
    const float* g0 = c.a.in[I_NORMG];
    for (int m = gw; m < M; m += NGW) {
        const float* xr = m < MPR ? c.a.in[I_XP] + (size_t)m * DM : c.a.in[I_XS] + (size_t)(m - MPR) * DM;
        rms_row_to_bf16(xr, g0, c.XN + (size_t)m * DM, c.lane);
    }
    const int gt = c.bx * 512 + c.tid, NT = gridDim.x * 512;
    for (int i = gt; i < 4096 * 64; i += NT) { const int pos = i >> 6, d = i & 63;
        const float freq = 1.0f / powf(10000.0f, (float)d * (1.0f / 64.0f)); const float ang = (float)pos * freq;
        float sn, cs; sincosf(ang, &sn, &cs); c.COS[i] = cs; c.SIN[i] = sn; }
}

DI u32x4 pack8(const float* p) { const f32x4 a = *(const f32x4*)p, b = *(const f32x4*)(p + 4); u32x4 r; r.x = pk2(a.x, a.y); r.y = pk2(a.z, a.w); r.z = pk2(b.x, b.y); r.w = pk2(b.z, b.w); return r; }
DI void swa_unit(Ctx& c, int u, int buf) {
    const int tid = c.tid, w = c.wave, l15 = c.l15, quad = c.quad;
    const bool sample = u >= 512;
    int b, hk, qrow0, krow0 = 0, nkt, ktb;
    if (!sample) { b = u >> 8; const int ch = (u >> 2) & 63; hk = u & 3; qrow0 = b * 4096 + ch * 64; krow0 = qrow0 - 128; nkt = 12; ktb = ch < 2 ? (2 - ch) * 4 : 0; }
    else { const int us = u - 512; b = us >> 2; hk = us & 3; qrow0 = MPR + b * 32; nkt = 10; ktb = 0; }
    LAS bf16* Ks = (LAS bf16*)(c.lds + buf * 65536);
    LAS bf16* Vs = (LAS bf16*)(c.lds + buf * 65536 + 192 * 144);
    for (int idx = tid; idx < nkt * 128; idx += 512) {
        const int kk = idx >> 3, seg = idx & 7;
        u32x4 kv = {0u, 0u, 0u, 0u}, vv = {0u, 0u, 0u, 0u};
        if (!sample) { if (kk >= ktb * 16) { const bf16* zr = c.Z + (size_t)(krow0 + kk) * EVEN_IN + hk * 64 + seg * 8; kv = *(const u32x4*)(zr + ZK); vv = *(const u32x4*)(zr + ZV); } }
        else if (kk < 128) { const size_t off = ((size_t)(b * 128 + kk) * 4 + hk) * 64 + seg * 8; kv = pack8(c.a.in[I_CK] + off); vv = pack8(c.a.in[I_CV] + off); }
        else { const bf16* zr = c.Z + (size_t)(qrow0 + kk - 128) * EVEN_IN + hk * 64 + seg * 8; kv = *(const u32x4*)(zr + ZK); vv = *(const u32x4*)(zr + ZV); }
        *(LAS u32x4*)(Ks + kk * 72 + seg * 8) = kv; *(LAS u32x4*)(Vs + kk * 72 + seg * 8) = vv;
    }
    const int head = hk * 4 + (w >> 1);
    const float sink = c.a.in[I_SINK][head];
    const int nqt = sample ? 1 : 2;
    bf16x8 Qall[2][2];
#pragma unroll
    for (int qt = 0; qt < 2; ++qt) { const int qloc = sample ? (w & 1) * 16 : (w & 1) * 32 + qt * 16; const size_t qrow = (size_t)(qrow0 + qloc + l15);
#pragma unroll
        for (int s = 0; s < 2; ++s) Qall[qt][s] = __builtin_nontemporal_load((const bf16x8*)(c.Z + qrow * EVEN_IN + ZQ + head * 64 + s * 32 + quad * 8)); }
    __syncthreads();
#pragma unroll
    for (int qt = 0; qt < 2; ++qt) {
        if (qt < nqt) {
        const int qloc = sample ? (w & 1) * 16 : (w & 1) * 32 + qt * 16;
        const size_t qrow = (size_t)(qrow0 + qloc + l15);
        bf16x8 Qf[2]; Qf[0] = Qall[qt][0]; Qf[1] = Qall[qt][1];
        f32x4 st[12];
        float mx = sink;
#pragma unroll
        for (int kt = 0; kt < 12; ++kt) {
            if (kt >= ktb && kt < nkt) {
                const bf16x8 a0 = *(const LAS bf16x8*)(Ks + (kt * 16 + l15) * 72 + quad * 8), a1 = *(const LAS bf16x8*)(Ks + (kt * 16 + l15) * 72 + 32 + quad * 8);
                f32x4 acc = {0.f, 0.f, 0.f, 0.f}; acc = MFMA16(a0, Qf[0], acc); acc = MFMA16(a1, Qf[1], acc);
                st[kt] = acc * 0.125f;
                mx = fmaxf(mx, fmaxf(fmaxf(st[kt][0], st[kt][1]), fmaxf(st[kt][2], st[kt][3])));
            } else st[kt] = (f32x4){-INFINITY, -INFINITY, -INFINITY, -INFINITY};
        }
        mx = fmaxf(mx, __shfl_xor(mx, 16)); mx = fmaxf(mx, __shfl_xor(mx, 32));
        float sum = 0.f;
#pragma unroll
        for (int kt = 0; kt < 12; ++kt)
#pragma unroll
            for (int e = 0; e < 4; ++e) { const float p = __expf(st[kt][e] - mx); st[kt][e] = p; sum += p; }
        sum += __shfl_xor(sum, 16); sum += __shfl_xor(sum, 32); sum += __expf(sink - mx);
        f32x4 O[4];
#pragma unroll
        for (int dt = 0; dt < 4; ++dt) O[dt] = (f32x4){0.f, 0.f, 0.f, 0.f};
#pragma unroll
        for (int kb = 0; kb < 6; ++kb) {
            if (kb * 2 < nkt && kb * 2 + 1 >= ktb) {
                u32x4 pw; pw.x = pk2(st[2 * kb][0], st[2 * kb][1]); pw.y = pk2(st[2 * kb][2], st[2 * kb][3]); pw.z = pk2(st[2 * kb + 1][0], st[2 * kb + 1][1]); pw.w = pk2(st[2 * kb + 1][2], st[2 * kb + 1][3]);
                const bf16x8 Pf = __builtin_bit_cast(bf16x8, pw);
#pragma unroll
                for (int dt = 0; dt < 4; ++dt) {
                    const bf16x8 Vf = trfrag(Vs, 72, kb * 32 + quad * 4, kb * 32 + 16 + quad * 4, dt * 16, l15);
                    O[dt] = MFMA16(Vf, Pf, O[dt]);
                }
            }
        }
        const float inv = 1.f / sum;
#pragma unroll
        for (int dt = 0; dt < 4; ++dt) { const f32x4 o = O[dt] * inv; u32x2 wv; wv.x = pk2(o.x, o.y); wv.y = pk2(o.z, o.w);
            *(u32x2*)(c.MIX + qrow * DM + head * 64 + dt * 16 + quad * 4) = wv; }
        }
    }
}

DI float ret_logg(int h) { return log1pf(-exp2f(-5.0f - (float)h)); }
DI void rope_frags(const bf16* zr  , const float* cosr  , const float* sinr, float scale, float (&f)[4][8]) {
    u32x4 x[4];
#pragma unroll
    for (int s = 0; s < 4; ++s) x[s] = *(const u32x4*)(zr + s * 32);
#pragma unroll
    for (int s2 = 0; s2 < 2; ++s2) {
        float cs[8], sn[8];
        *(f32x4*)&cs[0] = *(const f32x4*)(cosr + s2 * 32); *(f32x4*)&cs[4] = *(const f32x4*)(cosr + s2 * 32 + 4);
        *(f32x4*)&sn[0] = *(const f32x4*)(sinr + s2 * 32); *(f32x4*)&sn[4] = *(const f32x4*)(sinr + s2 * 32 + 4);
#pragma unroll
        for (int k = 0; k < 8; ++k) { const unsigned w1 = x[s2][k >> 1], w2 = x[s2 + 2][k >> 1];
            const float a = (k & 1) ? bfhi(w1) : bflo(w1), bb = (k & 1) ? bfhi(w2) : bflo(w2);
            f[s2][k] = (a * cs[k] - bb * sn[k]) * scale; f[s2 + 2][k] = (bb * cs[k] + a * sn[k]) * scale; }
    }
}
DI bf16x8 packf8(const float (&f)[8], float sc) { u32x4 r; r.x = pk2(f[0] * sc, f[1] * sc); r.y = pk2(f[2] * sc, f[3] * sc); r.z = pk2(f[4] * sc, f[5] * sc); r.w = pk2(f[6] * sc, f[7] * sc); return __builtin_bit_cast(bf16x8, r); }

DI void retkv_unit(Ctx& c, int u, int buf) {
    const int tid = c.tid, w = c.wave, l15 = c.l15, quad = c.quad;
    const bool sample = u >= 1024;
    int b, n = 0, h, row0, pos0, T;
    if (!sample) { b = u >> 9; n = (u >> 3) & 63; h = u & 7; row0 = b * 4096 + n * 64; pos0 = n * 64; T = 64; }
    else { const int us = u - 1024; b = us >> 3; h = us & 7; row0 = MPR + b * 32; pos0 = 1024; T = 32; }
    const float logg = ret_logg(h);
    LAS bf16* Kn = (LAS bf16*)(c.lds + buf * 65536);
    LAS bf16* Vn = (LAS bf16*)(c.lds + buf * 65536 + 64 * 288);
    for (int idx = tid; idx < T * 8; idx += 512) {
        const int j = idx >> 3, d0 = (idx & 7) * 8;
        const bf16* zr = c.Z + (size_t)(row0 + j) * EVEN_IN + ZRK + h * 128 + d0;
        const u32x4 x1 = *(const u32x4*)zr, x2 = *(const u32x4*)(zr + 64);
        const float* cr = c.COS + (size_t)(pos0 + j) * 64 + d0; const float* sr = c.SIN + (size_t)(pos0 + j) * 64 + d0;
        float cs[8], sn[8];
        *(f32x4*)&cs[0] = *(const f32x4*)cr; *(f32x4*)&cs[4] = *(const f32x4*)(cr + 4); *(f32x4*)&sn[0] = *(const f32x4*)sr; *(f32x4*)&sn[4] = *(const f32x4*)(sr + 4);
        const float dec = __expf(logg * (float)(T - 1 - j));
        float o1[8], o2[8];
#pragma unroll
        for (int k = 0; k < 8; ++k) { const unsigned w1 = x1[k >> 1], w2 = x2[k >> 1];
            const float a = (k & 1) ? bfhi(w1) : bflo(w1), bb = (k & 1) ? bfhi(w2) : bflo(w2);
            o1[k] = (a * cs[k] - bb * sn[k]) * 0.08838834764831845f; o2[k] = (bb * cs[k] + a * sn[k]) * 0.08838834764831845f;
        }
        { u32x4 q1, q2; q1.x = pk2(o1[0] * dec, o1[1] * dec); q1.y = pk2(o1[2] * dec, o1[3] * dec); q1.z = pk2(o1[4] * dec, o1[5] * dec); q1.w = pk2(o1[6] * dec, o1[7] * dec);
          q2.x = pk2(o2[0] * dec, o2[1] * dec); q2.y = pk2(o2[2] * dec, o2[3] * dec); q2.z = pk2(o2[4] * dec, o2[5] * dec); q2.w = pk2(o2[6] * dec, o2[7] * dec);
          *(LAS u32x4*)(Kn + j * 144 + d0) = q1; *(LAS u32x4*)(Kn + j * 144 + 64 + d0) = q2; }
        { bf16* kp = c.KP + (size_t)(row0 + j) * 1024 + h * 128 + d0;
          u32x4 p1, p2; p1.x = pk2(o1[0], o1[1]); p1.y = pk2(o1[2], o1[3]); p1.z = pk2(o1[4], o1[5]); p1.w = pk2(o1[6], o1[7]); p2.x = pk2(o2[0], o2[1]); p2.y = pk2(o2[2], o2[3]); p2.z = pk2(o2[4], o2[5]); p2.w = pk2(o2[6], o2[7]);
          *(u32x4*)kp = p1; *(u32x4*)(kp + 64) = p2; }
    }
    for (int idx = tid; idx < T * 16; idx += 512) {
        const int j = idx >> 4, e0 = (idx & 15) * 8;
        const u32x4 vv = *(const u32x4*)(c.Z + (size_t)(row0 + j) * EVEN_IN + ZRV + h * 128 + e0);
        *(LAS u32x4*)(Vn + j * 144 + e0) = vv;
    }
    __syncthreads();
    f32x4 acc[8];
#pragma unroll
    for (int dt = 0; dt < 8; ++dt) acc[dt] = (f32x4){0.f, 0.f, 0.f, 0.f};
#pragma unroll
    for (int s = 0; s < 2; ++s) {
        if (s * 32 < T) {
            const bf16x8 av = trfrag(Vn, 144, s * 32 + quad * 8, s * 32 + quad * 8 + 4, w * 16, l15);
#pragma unroll
            for (int dt = 0; dt < 8; ++dt) { const bf16x8 bk = trfrag(Kn, 144, s * 32 + quad * 8, s * 32 + quad * 8 + 4, dt * 16, l15); acc[dt] = MFMA16(av, bk, acc[dt]); }
        }
    }
    if (!sample) {
        float* o = c.KV + (size_t)((b * 64 + n) * 8 + h) * 16384;
#pragma unroll
        for (int dt = 0; dt < 8; ++dt) *(f32x4*)(o + (dt * 16 + l15) * 128 + w * 16 + quad * 4) = acc[dt];
    } else {
        const float cd = __expf(logg * 32.0f);
        const float* st = c.a.in[I_SRET] + (size_t)(b * 8 + h) * 16384; float* o = c.a.out + O_RS + (size_t)(b * 8 + h) * 16384;
#pragma unroll
        for (int dt = 0; dt < 8; ++dt) { const int off = (dt * 16 + l15) * 128 + w * 16 + quad * 4; *(f32x4*)(o + off) = *(const f32x4*)(st + off) * cd + acc[dt]; }
    }
}
DI void ret_scan(Ctx& c) {
    const int gt = c.bx * 512 + c.tid, NT = gridDim.x * 512;
    for (int i = gt; i < 16 * 8192; i += NT) {
        const int bh = i >> 13, off = (i & 8191) * 2, b = bh >> 3, h = bh & 7;
        const float cd = __expf(ret_logg(h) * 64.0f);
        float s0 = 0.f, s1 = 0.f;
        const float* kv = c.KV + (size_t)(b * 64 * 8 + h) * 16384 + off; bf16* st = c.STB + (size_t)(b * 64 * 8 + h) * 16384 + off;
#pragma unroll 16
        for (int n = 0; n < 64; ++n) { *(unsigned*)(st + (size_t)n * 8 * 16384) = pk2(s0, s1);
            const f32x2 v = __builtin_nontemporal_load((const f32x2*)(kv + (size_t)n * 8 * 16384)); s0 = cd * s0 + v.x; s1 = cd * s1 + v.y; }
        float* o = c.a.out + O_RP + (size_t)bh * 16384 + off; o[0] = s0; o[1] = s1;
    }
}
DI void retout_pair(Ctx& c, int pu) {
    const int tid = c.tid, w = c.wave, l15 = c.l15, quad = c.quad, sub = w >> 2, it = w & 3, t256 = tid & 255;
    const bool sample = pu >= 512;
    int b, n = 0, h, row0, pos0, T;
    if (!sample) { const int u = pu * 2 + sub; b = u >> 9; n = (u >> 3) & 63; h = u & 7; row0 = b * 4096 + n * 64; pos0 = n * 64; T = 64; }
    else { const int us = (pu - 512) * 2 + sub; b = us >> 3; h = us & 7; row0 = MPR + b * 32; pos0 = 1024; T = 32; }
    LAS bf16* Vn = (LAS bf16*)(c.lds + sub * 55296);
    LAS bf16* ST = Vn + 64 * 144;
    for (int idx = t256; idx < T * 16; idx += 256) {
        const int j = idx >> 4, e0 = (idx & 15) * 8;
        const u32x4 vv = *(const u32x4*)(c.Z + (size_t)(row0 + j) * EVEN_IN + ZRV + h * 128 + e0);
        *(LAS u32x4*)(Vn + j * 144 + e0) = vv;
    }
    if (!sample) { const bf16* src = c.STB + (size_t)((b * 64 + n) * 8 + h) * 16384;
        for (int idx = t256; idx < 2048; idx += 256) { const int d = idx >> 4, e0 = (idx & 15) * 8; *(LAS u32x4*)(ST + d * 144 + e0) = __builtin_nontemporal_load((const u32x4*)(src + d * 128 + e0)); } }
    else { const float* src = c.a.in[I_SRET] + (size_t)(b * 8 + h) * 16384;
        for (int idx = t256; idx < 4096; idx += 256) { const int d = idx >> 5, e0 = (idx & 31) * 4; const f32x4 v = *(const f32x4*)(src + d * 128 + e0);
            u32x2 pv; pv.x = pk2(v[0], v[1]); pv.y = pk2(v[2], v[3]); *(LAS u32x2*)(ST + d * 144 + e0) = pv; } }
    const float logg = ret_logg(h);
    const int i = (it * 16 < T) ? it * 16 + l15 : l15; const size_t rowi = (size_t)(row0 + i);
    bf16x8 Kf[4][4];
#pragma unroll
    for (int jt = 0; jt < 4; ++jt) { const int jtc = jt * 16 < T ? jt : 0; const bf16* kp = c.KP + (size_t)(row0 + jtc * 16 + l15) * 1024 + h * 128 + quad * 8;
#pragma unroll
        for (int s = 0; s < 4; ++s) Kf[jt][s] = *(const bf16x8*)(kp + s * 32); }
    bf16x8 Qf[4], Q2f[4];
    { float f4[4][8]; rope_frags(c.Z + rowi * EVEN_IN + ZRQ + h * 128 + quad * 8, c.COS + (size_t)(pos0 + i) * 64 + quad * 8, c.SIN + (size_t)(pos0 + i) * 64 + quad * 8, 1.0f, f4);
      const float qd = __expf(logg * (float)(i + 1));
#pragma unroll
      for (int s = 0; s < 4; ++s) { Qf[s] = packf8(f4[s], 1.0f); Q2f[s] = packf8(f4[s], qd); } }
    __syncthreads();
    if (it * 16 < T) {
        f32x4 sc[4];
#pragma unroll
        for (int jt = 0; jt < 4; ++jt) {
            if (jt <= it) {
                f32x4 acc = {0.f, 0.f, 0.f, 0.f};
#pragma unroll
                for (int s = 0; s < 4; ++s) acc = MFMA16(Kf[jt][s], Qf[s], acc);
#pragma unroll
                for (int e = 0; e < 4; ++e) { const int diff = i - (jt * 16 + quad * 4 + e); sc[jt][e] = diff >= 0 ? acc[e] * __expf(logg * (float)diff) : 0.f; }
            } else sc[jt] = (f32x4){0.f, 0.f, 0.f, 0.f};
        }
        f32x4 O[8];
#pragma unroll
        for (int et = 0; et < 8; ++et) O[et] = (f32x4){0.f, 0.f, 0.f, 0.f};
#pragma unroll
        for (int jb = 0; jb < 2; ++jb) {
            if (jb * 32 < T && jb * 2 <= it) {
                u32x4 pw; pw.x = pk2(sc[2 * jb][0], sc[2 * jb][1]); pw.y = pk2(sc[2 * jb][2], sc[2 * jb][3]); pw.z = pk2(sc[2 * jb + 1][0], sc[2 * jb + 1][1]); pw.w = pk2(sc[2 * jb + 1][2], sc[2 * jb + 1][3]);
                const bf16x8 Pf = __builtin_bit_cast(bf16x8, pw);
#pragma unroll
                for (int et = 0; et < 8; ++et) {
                    O[et] = MFMA16(trfrag(Vn, 144, jb * 32 + quad * 4, jb * 32 + 16 + quad * 4, et * 16, l15), Pf, O[et]);
                }
            }
        }
#pragma unroll
        for (int s = 0; s < 4; ++s)
#pragma unroll
            for (int et = 0; et < 8; ++et) { const bf16x8 Sf = trfrag(ST, 144, s * 32 + quad * 8, s * 32 + quad * 8 + 4, et * 16, l15); O[et] = MFMA16(Sf, Q2f[s], O[et]); }
        float sm = 0.f;
#pragma unroll
        for (int et = 0; et < 8; ++et) sm += (O[et][0] + O[et][1]) + (O[et][2] + O[et][3]);
        sm += __shfl_xor(sm, 16); sm += __shfl_xor(sm, 32);
        const float mu = sm * (1.0f / 128.0f); float q = 0.f;
#pragma unroll
        for (int et = 0; et < 8; ++et) { O[et] = O[et] - mu; q += dot4(O[et]); }
        q += __shfl_xor(q, 16); q += __shfl_xor(q, 32);
        const float rstd = 1.f / sqrtf(q * (1.0f / 128.0f) + EPS);
#pragma unroll
        for (int et = 0; et < 8; ++et) { const int e = h * 128 + et * 16 + quad * 4;
            const f32x4 g4 = *(const f32x4*)(c.a.in[I_RETG] + e); const u32x2 rgw = *(const u32x2*)(c.Z + rowi * EVEN_IN + ZRG + e);
            const float r0 = bflo(rgw.x), r1 = bfhi(rgw.x), r2 = bflo(rgw.y), r3 = bfhi(rgw.y);
            const f32x4 y = O[et] * rstd * g4;
            u32x2 wv; wv.x = pk2(y.x * (r0 / (1.f + __expf(-r0))), y.y * (r1 / (1.f + __expf(-r1)))); wv.y = pk2(y.z * (r2 / (1.f + __expf(-r2))), y.w * (r3 / (1.f + __expf(-r3))));
            *(u32x2*)(c.MIX + rowi * DM + 1024 + e) = wv; }
    }
    __syncthreads();
}
DI void swa_cache_out(Ctx& c) {
    const int gt = c.bx * 512 + c.tid, NT = gridDim.x * 512;
    float* out = c.a.out;
    for (int i = gt; i < 2 * 128 * 256; i += NT) {
        const int b = i >> 15, t = (i >> 8) & 127, cidx = i & 255; const size_t zr = (size_t)(b * 4096 + 3968 + t) * EVEN_IN;
        out[O_KP + i] = bflo((unsigned)c.Z[zr + ZK + cidx]); out[O_VP + i] = bflo((unsigned)c.Z[zr + ZV + cidx]);
    }
    for (int i = gt; i < 16 * 128 * 256; i += NT) {
        const int b = i >> 15, t = (i >> 8) & 127, cidx = i & 255;
        if (t < 96) { const size_t s = ((size_t)(b * 128 + t + 32)) * 256 + cidx; out[O_KS + i] = c.a.in[I_CK][s]; out[O_VS + i] = c.a.in[I_CV][s]; }
        else { const size_t zr = (size_t)(MPR + b * 32 + t - 96) * EVEN_IN; out[O_KS + i] = bflo((unsigned)c.Z[zr + ZK + cidx]); out[O_VS + i] = bflo((unsigned)c.Z[zr + ZV + cidx]); }
    }
}

DI void row_finish(Ctx& c, int m, f32x4 (&v)[8], const f32x4 (&hv)[8], const f32x4 (&gr)[8], const float* g_next) {
    const int lane = c.lane; float s = 0.f;
#pragma unroll
    for (int j = 0; j < 8; ++j) s += dot4(v[j]);
    const float r1 = 1.f / sqrtf(wave_sum(s) * (1.f / DM) + EPS);
    float s2 = 0.f;
#pragma unroll
    for (int j = 0; j < 8; ++j) { v[j] = hv[j] + v[j] * r1 * gr[j]; s2 += dot4(v[j]); __builtin_nontemporal_store(v[j], (f32x4*)(c.H + (size_t)m * DM) + lane + 64 * j); }
    if (g_next) {
        const float r2 = 1.f / sqrtf(wave_sum(s2) * (1.f / DM) + EPS);
#pragma unroll
        for (int j = 0; j < 8; ++j) { const f32x4 o = v[j] * r2 * ((const f32x4*)g_next)[lane + 64 * j]; u32x2 wv; wv.x = pk2(o.x, o.y); wv.y = pk2(o.z, o.w); ((u32x2*)(c.XN + (size_t)m * DM))[lane + 64 * j] = wv; }
    }
}
DI void row_pass(Ctx& c, bool from_x, const float* g_res, const float* g_next, const float* PB, int S) {
    const int gw = c.bx * 8 + c.wave, NGW = gridDim.x * 8, lane = c.lane;
    f32x4 gr[8];
#pragma unroll
    for (int j = 0; j < 8; ++j) gr[j] = ((const f32x4*)g_res)[lane + 64 * j];
    const int NSW = (M - MPR) < NGW / 2 ? (M - MPR) : 0;
    if (gw < NSW) {
        const int m = MPR + gw;
        const float* hs = from_x ? c.a.in[I_XS] + (size_t)(m - MPR) * DM : c.H + (size_t)m * DM;
        f32x4 v[8], hv[8];
#pragma unroll
        for (int j = 0; j < 8; ++j) { hv[j] = ((const f32x4*)hs)[lane + 64 * j]; v[j] = (f32x4){0.f, 0.f, 0.f, 0.f}; }
        for (int sl = 0; sl < S; sl += 2) {
            const u32x2* p0 = (const u32x2*)((const bf16*)PB + ((size_t)sl * 512 + (m - MPR)) * DM); const bool two = sl + 1 < S;
            const u32x2* p1 = (const u32x2*)((const bf16*)PB + ((size_t)(two ? sl + 1 : sl) * 512 + (m - MPR)) * DM);
            u32x2 a[8], b[8];
#pragma unroll
            for (int j = 0; j < 8; ++j) { a[j] = __builtin_nontemporal_load(p0 + lane + 64 * j); b[j] = __builtin_nontemporal_load(p1 + lane + 64 * j); }
#pragma unroll
            for (int j = 0; j < 8; ++j) { v[j] += (f32x4){bflo(a[j].x), bfhi(a[j].x), bflo(a[j].y), bfhi(a[j].y)}; if (two) v[j] += (f32x4){bflo(b[j].x), bfhi(b[j].x), bflo(b[j].y), bfhi(b[j].y)}; }
        }
        row_finish(c, m, v, hv, gr, g_next);
        const int NPW = NGW - NSW, rem0 = (MPR / NPW) * NPW, mx = rem0 + gw;
        if (MPR - rem0 <= NSW && mx < MPR) {
            const float* h0 = from_x ? c.a.in[I_XP] + (size_t)mx * DM : c.H + (size_t)mx * DM;
            f32x4 v2[8], h2[8];
#pragma unroll
            for (int j = 0; j < 8; ++j) { const u32x2 a0 = ((const u32x2*)(c.MPB + (size_t)mx * DM))[lane + 64 * j]; v2[j] = (f32x4){bflo(a0.x), bfhi(a0.x), bflo(a0.y), bfhi(a0.y)}; h2[j] = ((const f32x4*)h0)[lane + 64 * j]; }
            row_finish(c, mx, v2, h2, gr, g_next);
        }
    } else {
        const int pw = gw - NSW, NPW = NGW - NSW; const int rem0_ = (MPR / NPW) * NPW; const int mend = NSW ? ((MPR - rem0_ <= NSW) ? rem0_ : MPR) : M;
#define ROW_LOAD(m_, mpv, hv_) do { const int mm_ = (m_); \
            const float* hh_ = from_x ? (mm_ < MPR ? c.a.in[I_XP] + (size_t)mm_ * DM : c.a.in[I_XS] + (size_t)(mm_ - MPR) * DM) : c.H + (size_t)mm_ * DM; \
            _Pragma("unroll") for (int j = 0; j < 8; ++j) { mpv[j] = __builtin_nontemporal_load((const u32x2*)(c.MPB + (size_t)mm_ * DM) + lane + 64 * j); hv_[j] = __builtin_nontemporal_load((const f32x4*)hh_ + lane + 64 * j); } } while (0)
#define ROW_DONE(m_, mpv, hv_) do { f32x4 v_[8]; _Pragma("unroll") for (int j = 0; j < 8; ++j) v_[j] = (f32x4){bflo(mpv[j].x), bfhi(mpv[j].x), bflo(mpv[j].y), bfhi(mpv[j].y)}; row_finish(c, (m_), v_, hv_, gr, g_next); } while (0)
        u32x2 pa[8], pb[8]; f32x4 ha[8], hb[8];
        int m0 = pw;
        if (m0 < mend) ROW_LOAD(m0, pa, ha);
        for (; m0 < mend; m0 += 2 * NPW) {
            const int m1 = m0 + NPW; const bool two = m1 < mend;
            if (two) ROW_LOAD(m1, pb, hb);
            ROW_DONE(m0, pa, ha);
            const int m2 = m1 + NPW;
            if (m2 < mend) ROW_LOAD(m2, pa, ha);
            if (two) ROW_DONE(m1, pb, hb);
        }
#undef ROW_LOAD
#undef ROW_DONE
    }
}
DI void conv_gate(Ctx& c, int layer) {
    const int gt = c.bx * 512 + c.tid, NT = gridDim.x * 512;
    const float* cw = c.a.in[I_CW] + (size_t)layer * 3 * DFF2; const float* cb = c.a.in[I_CB] + (size_t)layer * DFF2;
    const float* stt = c.a.in[I_SCONV] + (size_t)layer * 16 * 2 * DFF2;
    constexpr int NCO = DFF / 8, NRB = M / 16;
    const int nrg = NT / NCO;
    const int co = gt % NCO, rg = gt / NCO;
    if (rg >= nrg) return;
    const int c0 = co * 8;
    f32x2 wa[3][4], wg[3][4], ba[4], bg[4];
#pragma unroll
    for (int i = 0; i < 3; ++i)
#pragma unroll
        for (int k = 0; k < 4; ++k) { wa[i][k] = *(const f32x2*)(cw + i * DFF2 + c0 + 2 * k); wg[i][k] = *(const f32x2*)(cw + i * DFF2 + DFF + c0 + 2 * k); }
#pragma unroll
    for (int k = 0; k < 4; ++k) { ba[k] = *(const f32x2*)(cb + c0 + 2 * k); bg[k] = *(const f32x2*)(cb + DFF + c0 + 2 * k); }
    for (int rb = rg; rb < NRB; rb += nrg) {
        const int r0 = rb * 16;
        f32x2 pa[2][4], pg[2][4];
        bool zero = false, fromstate = false; int sb = 0;
        if (r0 < MPR) zero = (r0 & 4095) == 0; else { const int rs = r0 - MPR; fromstate = (rs & 31) == 0; sb = rs >> 5; }
        u32x4 xa[4], xg[4];
#pragma unroll
        for (int r = 0; r < 4; ++r) { const bf16* hp = c.HRAW + (size_t)(r0 + r) * DFF2 + c0; xa[r] = __builtin_nontemporal_load((const u32x4*)hp); xg[r] = __builtin_nontemporal_load((const u32x4*)(hp + DFF)); }
#pragma unroll
        for (int p = 0; p < 2; ++p) {
            if (zero) {
#pragma unroll
                for (int k = 0; k < 4; ++k) { pa[p][k] = (f32x2){0.f, 0.f}; pg[p][k] = (f32x2){0.f, 0.f}; }
            } else if (fromstate) { const float* sp = stt + (size_t)(sb * 2 + p) * DFF2 + c0;
#pragma unroll
                for (int k = 0; k < 4; ++k) { pa[p][k] = *(const f32x2*)(sp + 2 * k); pg[p][k] = *(const f32x2*)(sp + DFF + 2 * k); }
            } else { const bf16* hp = c.HRAW + (size_t)(r0 - 2 + p) * DFF2 + c0; const u32x4 ya = *(const u32x4*)hp, yg = *(const u32x4*)(hp + DFF);
#pragma unroll
                for (int k = 0; k < 4; ++k) { pa[p][k] = (f32x2){bflo(ya[k]), bfhi(ya[k])}; pg[p][k] = (f32x2){bflo(yg[k]), bfhi(yg[k])}; } }
        }
#pragma unroll
        for (int q = 0; q < 4; ++q) {
            u32x4 na[4], ng[4];
            if (q < 3) {
#pragma unroll
                for (int r = 0; r < 4; ++r) { const bf16* hp = c.HRAW + (size_t)(r0 + 4 * (q + 1) + r) * DFF2 + c0; na[r] = __builtin_nontemporal_load((const u32x4*)hp); ng[r] = __builtin_nontemporal_load((const u32x4*)(hp + DFF)); }
            }
#pragma unroll
            for (int r = 0; r < 4; ++r) {
                u32x4 wv;
#pragma unroll
                for (int k = 0; k < 4; ++k) {
                    const f32x2 ca = (f32x2){bflo(xa[r][k]), bfhi(xa[r][k])}, cg = (f32x2){bflo(xg[r][k]), bfhi(xg[r][k])};
                    const f32x2 av = ba[k] + pa[0][k] * wa[0][k] + pa[1][k] * wa[1][k] + ca * wa[2][k];
                    const f32x2 gv = bg[k] + pg[0][k] * wg[0][k] + pg[1][k] * wg[1][k] + cg * wg[2][k];
                    const f32x2 t = gv * (-2.3022082f + -0.10294324f * (gv * gv));
                    f32x2 d; d.x = __builtin_amdgcn_exp2f(t.x); d.y = __builtin_amdgcn_exp2f(t.y); d = d + 1.0f;
                    f32x2 rc; rc.x = __builtin_amdgcn_rcpf(d.x); rc.y = __builtin_amdgcn_rcpf(d.y);
                    const f32x2 o = (gv * rc) * av;
                    wv[k] = pk2(o.x, o.y);
                    pa[0][k] = pa[1][k]; pa[1][k] = ca; pg[0][k] = pg[1][k]; pg[1][k] = cg;
                }
                *(u32x4*)(c.ACT + (size_t)(r0 + q * 4 + r) * DFF + c0) = wv;
            }
            if (q < 3) {
#pragma unroll
                for (int r = 0; r < 4; ++r) { xa[r] = na[r]; xg[r] = ng[r]; }
            }
        }
    }
}
DI void sgate_unit(Ctx& c, int u) {
    const int tid = c.tid, w = c.wave, l15 = c.l15, quad = c.quad;
    const bool sample = u >= 512;
    int g, row0, L, sb = 0;
    if (!sample) { g = u & 7; row0 = (u >> 3) * 128; L = 128; } else { const int us = u - 512; sb = us >> 3; g = us & 7; row0 = MPR + sb * 32; L = 32; }
    LAS bf16* VN = (LAS bf16*)c.lds;
    const float* lng = c.a.in[I_LNG] + g * 256; const float* lnb = c.a.in[I_LNB] + g * 256;
    int it, ct0, nct;
    if (!sample) { it = w; ct0 = 0; nct = 16; } else { it = w & 1; ct0 = (w >> 1) * 4; nct = 4; }
    const int i = it * 16 + l15;
    bf16x8 Wf[4];
    const float* wrow = c.a.in[I_GWS] + (size_t)(g * 128 + i) * 128 + quad * 8;
#pragma unroll
    for (int s = 0; s < 4; ++s) {
        if (s * 32 <= it * 16 + 15) { float f[8]; *(f32x4*)&f[0] = *(const f32x4*)(wrow + s * 32); *(f32x4*)&f[4] = *(const f32x4*)(wrow + s * 32 + 4);
#pragma unroll
            for (int k = 0; k < 8; ++k) if (s * 32 + quad * 8 + k > i) f[k] = 0.f;
            Wf[s] = packf8(f, 1.0f); }
        else Wf[s] = (bf16x8){0, 0, 0, 0, 0, 0, 0, 0};
    }
    const float bias = c.a.in[I_GBS][g * 128 + i];
    const size_t row = (size_t)(row0 + i);
    u32x2 uw[16];
#pragma unroll
    for (int cti = 0; cti < 16; ++cti) if (cti < nct) uw[cti] = __builtin_nontemporal_load((const u32x2*)(c.UV + row * 4096 + g * 256 + (ct0 + cti) * 16 + quad * 4));
    {
        u32x4 vv[8]; float mean[8], rstd[8];
        const int c0 = (tid & 31) * 8;
        float lg[8], lb[8];
        *(f32x4*)&lg[0] = *(const f32x4*)(lng + c0); *(f32x4*)&lg[4] = *(const f32x4*)(lng + c0 + 4); *(f32x4*)&lb[0] = *(const f32x4*)(lnb + c0); *(f32x4*)&lb[4] = *(const f32x4*)(lnb + c0 + 4);
#pragma unroll
        for (int t = 0; t < 8; ++t) { const int j = (tid >> 5) + 16 * t;
            if (j < L) { const size_t row = (size_t)(row0 + j); vv[t] = __builtin_nontemporal_load((const u32x4*)(c.UV + row * 4096 + 2048 + g * 256 + c0));
                const float2 st2 = *(const float2*)(c.STATS + 2 * row); mean[t] = st2.x * (1.f / 2048.f); const float var = st2.y * (1.f / 2048.f) - mean[t] * mean[t]; rstd[t] = 1.f / sqrtf(fmaxf(var, 0.f) + EPS); } }
#pragma unroll
        for (int t = 0; t < 8; ++t) { const int j = (tid >> 5) + 16 * t;
            if (j < L) { float vn[8];
#pragma unroll
                for (int k = 0; k < 8; ++k) { const float x = (k & 1) ? bfhi(vv[t][k >> 1]) : bflo(vv[t][k >> 1]); vn[k] = (x - mean[t]) * rstd[t] * lg[k] + lb[k]; }
                { u32x4 pv; pv.x = pk2(vn[0], vn[1]); pv.y = pk2(vn[2], vn[3]); pv.z = pk2(vn[4], vn[5]); pv.w = pk2(vn[6], vn[7]); *(LAS u32x4*)(VN + j * 272 + c0) = pv; }
                if (sample) { float* go = c.a.out + O_GV + (size_t)(sb * 32 + j) * 2048 + g * 256 + c0; *(f32x4*)go = *(f32x4*)&vn[0]; *(f32x4*)(go + 4) = *(f32x4*)&vn[4]; } } }
    }
    __syncthreads();
#pragma unroll
    for (int cti = 0; cti < 16; ++cti) {
        if (cti < nct) {
            const int ct = ct0 + cti; f32x4 acc = {0.f, 0.f, 0.f, 0.f};
#pragma unroll
            for (int s = 0; s < 4; ++s) if (s * 32 <= it * 16 + 15) { const bf16x8 av = trfrag(VN, 272, s * 32 + quad * 8, s * 32 + quad * 8 + 4, ct * 16, l15); acc = MFMA16(av, Wf[s], acc); }
            const int col = g * 256 + ct * 16 + quad * 4;
            u32x2 wv; wv.x = pk2(bflo(uw[cti].x) * (acc[0] + bias), bfhi(uw[cti].x) * (acc[1] + bias)); wv.y = pk2(bflo(uw[cti].y) * (acc[2] + bias), bfhi(uw[cti].y) * (acc[3] + bias));
            *(u32x2*)(c.MIX + row * DM + col) = wv;
        }
    }
    __syncthreads();
}

#define RLX_AGENT __ATOMIC_RELAXED, __HIP_MEMORY_SCOPE_AGENT
#define XB_TMO      128
#define XB_XCNT(j)  (256  + 64 * (j))
#define XB_XSUB(j)  (1280 + 64 * (j))
#define XB_XGEN(j)  (2304 + 64 * (j))
#define XB_TOP      3328
#define XB_TOPGEN   3392
#define XCD_BAR_WORDS 3456
#define XB_SPIN_CAP (1u << 18)

__device__ __forceinline__ unsigned xb_ld(unsigned* p)              { return __hip_atomic_load(p, __ATOMIC_RELAXED, __HIP_MEMORY_SCOPE_AGENT); }
__device__ __forceinline__ unsigned xb_add(unsigned* p, unsigned v) { return __hip_atomic_fetch_add(p, v, __ATOMIC_RELAXED, __HIP_MEMORY_SCOPE_AGENT); }
__device__ __forceinline__ unsigned xb_xcc_id() { return (unsigned)__builtin_amdgcn_s_getreg((3 << 11) | 20) & 0xFu; }
#define XB_SPIN(cond, bar) do { unsigned _sp = 0; while (cond) { __builtin_amdgcn_s_sleep(1); \
    if ((++_sp & 255u) == 0u) { if (xb_ld(&(bar)[XB_TMO])) break; if (_sp > XB_SPIN_CAP) { atomicAdd(&(bar)[XB_TMO], 1u); break; } } } } while (0)

struct XcdBarrier {
    unsigned* bar; unsigned x;
    volatile LAS unsigned* st;
};

__device__ __forceinline__ XcdBarrier xcd_barrier_post(unsigned* bar, volatile LAS unsigned* st) {
    XcdBarrier b; b.bar = bar; b.x = xb_xcc_id(); b.st = st;
    if (threadIdx.x == 0) (void)xb_add(&bar[XB_XCNT(b.x)], 1u);
    return b;
}
__device__ __forceinline__ void xcd_barrier_complete(unsigned* bar, unsigned x, unsigned& nloc, unsigned& nx) {
    const unsigned G = gridDim.x * gridDim.y * gridDim.z;
    unsigned sum, cnt, mine, sp = 0u;
    for (;;) {
        sum = 0u; cnt = 0u; mine = 0u;
#pragma unroll
        for (unsigned j = 0; j < 16; ++j) { const unsigned c = xb_ld(&bar[XB_XCNT(j)]); sum += c; cnt += (c > 0u) ? 1u : 0u; mine = (j == x) ? c : mine; }
        if (sum == G) break;
        __builtin_amdgcn_s_sleep(1);
        if ((++sp & 255u) == 0u) { if (xb_ld(&bar[XB_TMO])) break; if (sp > XB_SPIN_CAP) { atomicAdd(&bar[XB_TMO], 1u); break; } }
    }
    nloc = mine > 0u ? mine : 1u; nx = cnt > 0u ? cnt : 1u;
}

__device__ __forceinline__ void xcd_barrier(const XcdBarrier& b) {
    asm volatile("s_waitcnt vmcnt(0)" ::: "memory");
    __syncthreads();
    if (threadIdx.x == 0) {
        unsigned* bar = b.bar;
        __builtin_amdgcn_s_waitcnt(0);
        unsigned nloc = b.st[0], nx = b.st[1];
        if (nloc == 0u) { xcd_barrier_complete(bar, b.x, nloc, nx); b.st[0] = nloc; b.st[1] = nx; }
        const unsigned old = xb_add(&bar[XB_XSUB(b.x)], 1u);
        const unsigned gen = old / nloc;
        if (old + 1u == (gen + 1u) * nloc) {
            __builtin_amdgcn_fence(__ATOMIC_RELEASE, "agent");
            asm volatile("s_waitcnt vmcnt(0)" ::: "memory");
            const unsigned og = xb_add(&bar[XB_TOP], 1u);
            const unsigned tg = og / nx;
            if (og + 1u == (tg + 1u) * nx) xb_add(&bar[XB_TOPGEN], 1u);
            else XB_SPIN(xb_ld(&bar[XB_TOPGEN]) == tg, bar);
            __builtin_amdgcn_fence(__ATOMIC_ACQUIRE, "agent");
            xb_add(&bar[XB_XGEN(b.x)], 1u);
            asm volatile("s_waitcnt vmcnt(0)" ::: "memory");
        } else {
            XB_SPIN(xb_ld(&bar[XB_XGEN(b.x)]) == gen, bar);
            __builtin_amdgcn_fence(__ATOMIC_ACQUIRE, "agent");
            asm volatile("s_waitcnt vmcnt(0)" ::: "memory");
        }
    }
    __syncthreads();
}

__global__ void __launch_bounds__(512, 2) mega(const float* i0, const float* i1, const float* i2, const float* i3, const float* i4, const float* i5, const float* i6, const float* i7, const float* i8, const float* i9, const float* i10, const float* i11, const float* i12, const float* i13, const float* i14, const float* i15, const float* i16, const float* i17, const float* i18, const float* i19, const float* i20, float* out_, unsigned char* ws_, int ph_lo_, int ph_hi_) {
    Args args; args.in[0] = i0; args.in[1] = i1; args.in[2] = i2; args.in[3] = i3; args.in[4] = i4; args.in[5] = i5; args.in[6] = i6; args.in[7] = i7; args.in[8] = i8; args.in[9] = i9; args.in[10] = i10; args.in[11] = i11; args.in[12] = i12; args.in[13] = i13; args.in[14] = i14; args.in[15] = i15; args.in[16] = i16; args.in[17] = i17; args.in[18] = i18; args.in[19] = i19; args.in[20] = i20; args.out = out_; args.ws = ws_; args.ph_lo = ph_lo_; args.ph_hi = ph_hi_;
    extern __shared__ __attribute__((aligned(16))) unsigned char lds_raw[];
    cg::grid_group grid = cg::this_grid();
    { volatile LAS unsigned* st0 = (volatile LAS unsigned*)((LAS unsigned char*)lds_raw + 131072); if (threadIdx.x < 64) st0[threadIdx.x] = 0u; }
    __syncthreads();
    XcdBarrier xbar = xcd_barrier_post((unsigned*)(args.ws + WS_CTL), (volatile LAS unsigned*)((LAS unsigned char*)lds_raw + 131072));
    for (int pi = args.ph_lo; pi < args.ph_hi; ++pi) {
#if defined(PROBE_A)
    const int ph = pi <= PROBE_A ? pi : (pi - 1 <= PROBE_B ? pi - 1 : pi - 2);
#else
    const int ph = pi;
#endif
    Ctx c;
    { int t_ = threadIdx.x; asm volatile("" : "+v"(t_)); c.tid = t_; }
    c.lds = (LAS unsigned char*)lds_raw; c.lane = c.tid & 63; c.wave = __builtin_amdgcn_readfirstlane(c.tid >> 6); c.l15 = c.lane & 15; c.quad = c.lane >> 4; c.a = args;
    size_t zoff = 0; asm volatile("" : "+s"(zoff));
    unsigned char* ws = args.ws + zoff;
    int bx = blockIdx.x; asm volatile("" : "+s"(bx));
    const int G = gridDim.x; c.bx = bx;
    c.Z = (bf16*)(ws + WS_Z); c.XN = (bf16*)(ws + WS_XN); c.MIX = (bf16*)(ws + WS_MIX); c.ACT = (bf16*)(ws + WS_ACT); c.HRAW = (bf16*)(ws + WS_HRAW); c.UV = (bf16*)(ws + WS_UV); c.STB = (bf16*)(ws + WS_ST); c.KP = (bf16*)(ws + WS_KP);
    c.MPB = (bf16*)(ws + WS_MPB); c.KV = (float*)(ws + WS_KV); c.COS = (float*)(ws + WS_COS); c.SIN = (float*)(ws + WS_SIN); c.STATS = (float*)(ws + WS_STATS); c.H = args.out + O_Y;
#if defined(STAGGER_TICKS)
        if ((ph == PH_WIN_E || ph == PH_UP0 || ph == PH_UP1 || ph == PH_WIN_O) && (bx & 1)) { const unsigned long long t0 = __builtin_amdgcn_s_memrealtime(); while (__builtin_amdgcn_s_memrealtime() - t0 < STAGGER_TICKS) __builtin_amdgcn_s_sleep(8); }
#endif
        if (ph == PH_PRO) prologue(c);
        else if (ph == PH_WIN_E) {
            pg8::Gemm g{c.XN, (const bf16*)(ws + WS_WINE), M, EVEN_IN, DM}; pg8::StaticOrder S; S.init(M, EVEN_IN, G, bx, DM);
            pg8::EpiBf16 E{c.Z, EVEN_IN};
            pg8::gemm_phase<pg8::EpiBf16, pg8::StaticOrder, true, true>(c.lds, g, S, E);
        } else if (ph == PH_MIXA) {
            { int k = 0; for (int u = bx; u < 576 + 1152; u += G, k ^= 1) { if (u < 576) swa_unit(c, u, k); else retkv_unit(c, u - 576, k); } }
            swa_cache_out(c);
        } else if (ph == PH_SCAN) ret_scan(c);
        else if (ph == PH_MIXC) { for (int u = bx; u < 576; u += G) retout_pair(c, u); }
        else if (ph == PH_WOUT_E || ph == PH_WOUT_O || ph == PH_DOWN0 || ph == PH_DOWN1) {
            const bool dn = (ph == PH_DOWN0 || ph == PH_DOWN1); const int K = dn ? DFF : DM;
            const bf16* A = dn ? c.ACT : c.MIX;
            const bf16* B = ph == PH_WOUT_E ? (const bf16*)(ws + WS_WOUTE) : ph == PH_WOUT_O ? (const bf16*)(ws + WS_WOUTO) : (const bf16*)(ws + WS_WDN) + (ph == PH_DOWN1 ? (size_t)DFF * DM : 0);
            pg8::Gemm g{A, B, M, DM, K}; pg8::SplitOrder S; S.init(MPR, M - MPR, DM, K, G, bx, dn ? 11 : 8);
            pg8::EpiF32 E{c.MPB, DM, (float*)(ws + WS_PB), MPR / 256};
            pg8::gemm_phase<pg8::EpiF32, pg8::SplitOrder, true, true>(c.lds, g, S, E);
        } else if (ph == PH_UP0 || ph == PH_UP1) {
            const int L = ph == PH_UP1;
            pg8::Gemm g{c.XN, (const bf16*)(ws + WS_WUP) + (size_t)L * DFF2 * DM, M, DFF2, DM}; pg8::StaticOrder S; S.init(M, DFF2, G, bx, DM);
            pg8::EpiUp E{c.HRAW, DFF2, args.out + O_CP + (size_t)L * 2 * 2 * DFF2, args.out + O_CS + (size_t)L * 16 * 2 * DFF2};
            pg8::gemm_phase<pg8::EpiUp, pg8::StaticOrder, true, true>(c.lds, g, S, E);
        } else if (ph == PH_CONV0 || ph == PH_CONV1) conv_gate(c, ph == PH_CONV1);
        else if (ph == PH_ROWA0) row_pass(c, true, args.in[I_NORMG] + 1 * DM, args.in[I_NORMG] + 2 * DM, (const float*)(ws + WS_PB), 8);
        else if (ph == PH_ROWB0) row_pass(c, false, args.in[I_NORMG] + 3 * DM, args.in[I_NORMG] + 4 * DM, (const float*)(ws + WS_PB), 11);
        else if (ph == PH_ROWA1) row_pass(c, false, args.in[I_NORMG] + 5 * DM, args.in[I_NORMG] + 6 * DM, (const float*)(ws + WS_PB), 8);
        else if (ph == PH_ROWB1) row_pass(c, false, args.in[I_NORMG] + 7 * DM, nullptr, (const float*)(ws + WS_PB), 11);
        else if (ph == PH_WIN_O) {
            pg8::Gemm g{c.XN, (const bf16*)(ws + WS_WINO), M, 4096, DM}; pg8::StaticOrder S; S.init(M, 4096, G, bx, DM);
            pg8::EpiGeluStats E{c.UV, 4096, c.STATS, 2048};
            pg8::gemm_phase<pg8::EpiGeluStats, pg8::StaticOrder, true, true>(c.lds, g, S, E);
        } else if (ph == PH_SGATE) { for (int u = bx; u < 640; u += G) sgate_unit(c, u); }
        if (pi + 1 < args.ph_hi) { if (pi == args.ph_lo) grid.sync(); else xcd_barrier(xbar); }
    }
}

extern "C" void kernel_launch(void* const* d_in, const int* in_sizes, int n_in, void* d_out, int out_size, void* d_ws, size_t ws_size, hipStream_t stream) {
    static int grid = 0;
    if (grid == 0) {
        if (n_in != 21 || (size_t)out_size != O_END || ws_size < WS_END) { fprintf(stderr, "kernel_launch: unexpected shapes: n_in %d out %d ws %zu\n", n_in, out_size, ws_size); grid = -1; return; }
        int dev = 0, cus = 0, per_cu = 0;
        hipGetDevice(&dev); hipDeviceGetAttribute(&cus, hipDeviceAttributeMultiprocessorCount, dev);
        hipFuncSetAttribute((const void*)mega, hipFuncAttributeMaxDynamicSharedMemorySize, LDS_BYTES);
        if (hipOccupancyMaxActiveBlocksPerMultiprocessor(&per_cu, (const void*)mega, 512, LDS_BYTES) != hipSuccess || per_cu < 1) { fprintf(stderr, "kernel_launch: occupancy query says %d\n", per_cu); per_cu = 1; }
        (void)hipGetLastError();
        grid = cus * 1;
    }
    if (grid < 0) return;
    hipMemsetAsync((char*)d_ws + WS_CTL, 0, CTL_BYTES, stream);
    Args a{};
    for (int i = 0; i < 21; ++i) a.in[i] = (const float*)d_in[i];
    a.out = (float*)d_out; a.ws = (unsigned char*)d_ws;
#if ONE_LAUNCH
#if defined(PROBE_A)
    a.ph_lo = 0; a.ph_hi = NPH + 1 + (PROBE_B < NPH ? 1 : 0);
#else
    a.ph_lo = 0; a.ph_hi = NPH;
#endif
    void* kargs[25]; for (int i = 0; i < 21; ++i) kargs[i] = (void*)&a.in[i];
    kargs[21] = (void*)&a.out; kargs[22] = (void*)&a.ws; kargs[23] = (void*)&a.ph_lo; kargs[24] = (void*)&a.ph_hi;
    hipError_t e = hipLaunchCooperativeKernel((const void*)mega, dim3(grid), dim3(512), kargs, LDS_BYTES, stream);
    if (e != hipSuccess) fprintf(stderr, "cooperative launch failed: %s (grid %d)\n", hipGetErrorString(e), grid);
#else
    for (int ph = 0; ph < NPH; ++ph) { hipLaunchKernelGGL(mega, dim3(grid), dim3(512), LDS_BYTES, stream, a.in[0], a.in[1], a.in[2], a.in[3], a.in[4], a.in[5], a.in[6], a.in[7], a.in[8], a.in[9], a.in[10], a.in[11], a.in[12], a.in[13], a.in[14], a.in[15], a.in[16], a.in[17], a.in[18], a.in[19], a.in[20], a.out, a.ws, ph, ph + 1); }
#endif
}
```
